# Optimizing an MI355X kernel written in HIP

```python
import jax, jax.numpy as jnp
from jax import lax
import numpy as np

D_MODEL = 1024
BATCH = 8
SEQ = 8192
DEPTH = 4

N_MIXERS = 2
N_MLA_LAYERS = (DEPTH + 1) // 2
N_RWKV_LAYERS = DEPTH // 2
NORM_EPS = 1e-6

MLA_HEADS = 8
QK_NOPE_DIM = 128
QK_ROPE_DIM = 64
V_HEAD_DIM = 128
Q_LORA = 768
KV_LORA = 256
MLA_WIDTH = MLA_HEADS * V_HEAD_DIM
MLA_IN = Q_LORA + KV_LORA + QK_ROPE_DIM + MLA_WIDTH
ROPE_THETA = 10000.0
BLOCK = 128
MAX_POS_OFFSET = 4096

RWKV_HEAD = 64
RWKV_HEADS = D_MODEL // RWKV_HEAD
RWKV_WIDTH = RWKV_HEADS * RWKV_HEAD
DECAY_LORA = 64
ICLR_LORA = 64
RWKV_IN = 4 * RWKV_WIDTH + DECAY_LORA + ICLR_LORA
GN_EPS = 64e-5

kernel_name = 'hybrid_mla_rwkv7_gated'


def rms_norm(x, g):
    xf = x.astype(jnp.float32)
    y = xf * lax.rsqrt(jnp.mean(xf * xf, axis=-1, keepdims=True) + NORM_EPS)
    return (y * g.astype(jnp.float32)).astype(x.dtype)


def apply_rope(t, positions):
    half = t.shape[-1] // 2
    inv_freq = 1.0 / (ROPE_THETA ** (jnp.arange(half, dtype=jnp.float32) / half))
    ang = positions.astype(jnp.float32)[:, :, None] * inv_freq
    cos = jnp.cos(ang)[:, :, None, :]
    sin = jnp.sin(ang)[:, :, None, :]
    tf = t.astype(jnp.float32)
    t1, t2 = tf[..., :half], tf[..., half:]
    return jnp.concatenate([t1 * cos - t2 * sin, t2 * cos + t1 * sin], axis=-1).astype(t.dtype)


def block_causal_attention(q, k, v):
    bsz, n_heads, seq, dqk = q.shape
    dv = v.shape[-1]
    n_blocks = seq // BLOCK
    scale = dqk ** -0.5
    offs = jnp.arange(BLOCK)

    def query_block(qi):
        q_start = qi * BLOCK
        qb = lax.dynamic_slice_in_dim(q, q_start, BLOCK, axis=2).astype(jnp.float32) * scale
        q_idx = q_start + offs

        def key_block(kb, carry):
            m, l, acc = carry
            k_start = kb * BLOCK
            kblk = lax.dynamic_slice_in_dim(k, k_start, BLOCK, axis=2).astype(jnp.float32)
            vblk = lax.dynamic_slice_in_dim(v, k_start, BLOCK, axis=2).astype(jnp.float32)
            s = jnp.einsum('bhqd,bhkd->bhqk', qb, kblk)
            s = jnp.where((k_start + offs)[None, :] <= q_idx[:, None], s, -jnp.inf)
            m_new = jnp.maximum(m, s.max(axis=-1))
            p = jnp.exp(s - m_new[..., None])
            corr = jnp.exp(m - m_new)
            l_new = l * corr + p.sum(axis=-1)
            acc_new = acc * corr[..., None] + jnp.einsum('bhqk,bhkd->bhqd', p, vblk)
            return (m_new, l_new, acc_new)

        init = (jnp.full((bsz, n_heads, BLOCK), -jnp.inf, jnp.float32),
                jnp.zeros((bsz, n_heads, BLOCK), jnp.float32),
                jnp.zeros((bsz, n_heads, BLOCK, dv), jnp.float32))
        _, l, acc = lax.fori_loop(0, qi + 1, key_block, init)
        return (acc / l[..., None]).astype(v.dtype)

    out = lax.map(query_block, jnp.arange(n_blocks))
    return out.transpose(1, 0, 3, 2, 4).reshape(bsz, seq, n_heads, dv)


def mla_mixer(h, positions, w_in, q_norm, w_uq, kv_norm, w_ukv, w_out):
    bsz, seq, _ = h.shape
    proj = h @ w_in
    q_lat, kv_lat, k_rope, gate = jnp.split(
        proj, [Q_LORA, Q_LORA + KV_LORA, Q_LORA + KV_LORA + QK_ROPE_DIM], axis=-1)
    q = (rms_norm(q_lat, q_norm) @ w_uq).reshape(bsz, seq, MLA_HEADS, QK_NOPE_DIM + QK_ROPE_DIM)
    q_nope, q_rope = q[..., :QK_NOPE_DIM], q[..., QK_NOPE_DIM:]
    q_rope = apply_rope(q_rope, positions)
    kv = (rms_norm(kv_lat, kv_norm) @ w_ukv).reshape(bsz, seq, MLA_HEADS, QK_NOPE_DIM + V_HEAD_DIM)
    k_nope, v = kv[..., :QK_NOPE_DIM], kv[..., QK_NOPE_DIM:]
    k_rope = apply_rope(k_rope[:, :, None, :], positions)
    q_full = jnp.concatenate([q_nope, q_rope], axis=-1)
    k_full = jnp.concatenate(
        [k_nope, jnp.broadcast_to(k_rope, (bsz, seq, MLA_HEADS, QK_ROPE_DIM))], axis=-1)
    o = block_causal_attention(q_full.transpose(0, 2, 1, 3), k_full.transpose(0, 2, 1, 3),
                               v.transpose(0, 2, 1, 3))
    o = o.reshape(bsz, seq, MLA_WIDTH) * jax.nn.silu(gate)
    return o @ w_out


def token_shift(y):
    return jnp.pad(y, ((0, 0), (1, 0), (0, 0)))[:, :-1]


def wkv7_scan(r, w, k, v, a_vec, b_vec):
    bsz, _, n_heads, n = r.shape

    def step(state, inp):
        r_t, w_t, k_t, v_t, a_t, b_t = inp
        sa = jnp.einsum('bhij,bhj->bhi', state, a_t)
        state = (state * w_t[:, :, None, :] + sa[..., None] * b_t[:, :, None, :]
                 + v_t[..., None] * k_t[:, :, None, :])
        return state, jnp.einsum('bhij,bhj->bhi', state, r_t)

    xs = tuple(jnp.moveaxis(t, 1, 0) for t in (r, w, k, v, a_vec, b_vec))
    state0 = jnp.zeros((bsz, n_heads, n, n), jnp.float32)
    _, ys = lax.scan(step, state0, xs)
    return jnp.moveaxis(ys, 0, 1)


def rwkv7_mixer(h, w_in, mu, w0, w_w2, a0, w_a2, k_k, k_a, r_k, ln_g, ln_b, w_out):
    bsz, seq, _ = h.shape
    proj = h @ w_in
    proj = proj + mu * (token_shift(proj) - proj)
    r, k, v, g, wd, ad = jnp.split(
        proj, [RWKV_WIDTH, 2 * RWKV_WIDTH, 3 * RWKV_WIDTH, 4 * RWKV_WIDTH,
               4 * RWKV_WIDTH + DECAY_LORA], axis=-1)
    w_log = -jax.nn.softplus(-(w0 + jnp.tanh(wd) @ w_w2)) - 0.5
    decay = jnp.exp(-jnp.exp(w_log.astype(jnp.float32)))
    a = jax.nn.sigmoid(a0 + ad @ w_a2)

    def heads(t):
        return t.reshape(bsz, seq, RWKV_HEADS, RWKV_HEAD).astype(jnp.float32)

    kk = heads(k * k_k)
    kk = kk / jnp.maximum(jnp.sqrt(jnp.sum(kk * kk, axis=-1, keepdims=True)), 1e-12)
    k = k * (1.0 + (a - 1.0) * k_a)
    r_h, k_h, v_h, a_h, w_h = heads(r), heads(k), heads(v), heads(a), heads(decay)
    y = wkv7_scan(r_h, w_h, k_h, v_h, -kk, kk * a_h)
    mean = jnp.mean(y, axis=-1, keepdims=True)
    var = jnp.mean(jnp.square(y - mean), axis=-1, keepdims=True)
    y = (y - mean) * lax.rsqrt(var + GN_EPS)
    y = (y * ln_g.reshape(RWKV_HEADS, RWKV_HEAD).astype(jnp.float32)
         + ln_b.reshape(RWKV_HEADS, RWKV_HEAD).astype(jnp.float32))
    bonus = jnp.sum(r_h * k_h * r_k.reshape(RWKV_HEADS, RWKV_HEAD).astype(jnp.float32),
                    axis=-1, keepdims=True)
    y = y + bonus * v_h
    y = y.reshape(bsz, seq, RWKV_WIDTH).astype(h.dtype) * jax.nn.silu(g)
    return y @ w_out


def setup_inputs(seed: int = 0) -> dict:
    key = jax.random.key(seed)
    ks = jax.random.split(key, 24)

    def nrm(k, shape, scale):
        return scale * jax.random.normal(k, shape, jnp.float32)

    nm, nr, w = N_MLA_LAYERS, N_RWKV_LAYERS, RWKV_WIDTH
    x = jax.random.normal(ks[0], (BATCH, SEQ, D_MODEL), jnp.float32)
    offsets = jax.random.randint(ks[1], (BATCH, 1), 0, MAX_POS_OFFSET, jnp.int32)
    positions = offsets + jnp.arange(SEQ, dtype=jnp.int32)[None, :]
    norm_g = 1.0 + nrm(ks[2], (DEPTH, D_MODEL), 0.02)
    mla_w_in = nrm(ks[3], (nm, D_MODEL, MLA_IN), D_MODEL ** -0.5)
    mla_q_norm = 1.0 + nrm(ks[4], (nm, Q_LORA), 0.02)
    mla_w_uq = nrm(ks[5], (nm, Q_LORA, MLA_HEADS * (QK_NOPE_DIM + QK_ROPE_DIM)), Q_LORA ** -0.5)
    mla_kv_norm = 1.0 + nrm(ks[6], (nm, KV_LORA), 0.02)
    mla_w_ukv = nrm(ks[7], (nm, KV_LORA, MLA_HEADS * (QK_NOPE_DIM + V_HEAD_DIM)), KV_LORA ** -0.5)
    mla_w_out = nrm(ks[8], (nm, MLA_WIDTH, D_MODEL), MLA_WIDTH ** -0.5)
    rwkv_w_in = nrm(ks[9], (nr, D_MODEL, RWKV_IN), D_MODEL ** -0.5)
    rwkv_mu = jax.random.uniform(ks[10], (nr, RWKV_IN), jnp.float32)
    decay_base = jnp.linspace(-6.0, -1.0, w, dtype=jnp.float32)
    rwkv_w0 = decay_base[None, :] + nrm(ks[11], (nr, w), 0.1)
    rwkv_w_w2 = nrm(ks[12], (nr, DECAY_LORA, w), 0.5 * DECAY_LORA ** -0.5)
    rwkv_a0 = nrm(ks[13], (nr, w), 0.1)
    rwkv_w_a2 = nrm(ks[14], (nr, ICLR_LORA, w), ICLR_LORA ** -0.5)
    rwkv_k_k = 0.85 + nrm(ks[15], (nr, w), 0.02)
    rwkv_k_a = 1.0 + nrm(ks[16], (nr, w), 0.02)
    rwkv_r_k = nrm(ks[17], (nr, w), 0.1)
    rwkv_ln_g = 1.0 + nrm(ks[18], (nr, w), 0.02)
    rwkv_ln_b = nrm(ks[19], (nr, w), 0.02)
    rwkv_w_out = nrm(ks[20], (nr, w, D_MODEL), w ** -0.5)
    final_g = 1.0 + nrm(ks[21], (D_MODEL,), 0.02)
    return {'x': x, 'positions': positions, 'norm_g': norm_g,
            'mla_w_in': mla_w_in, 'mla_q_norm': mla_q_norm, 'mla_w_uq': mla_w_uq,
            'mla_kv_norm': mla_kv_norm, 'mla_w_ukv': mla_w_ukv, 'mla_w_out': mla_w_out,
            'rwkv_w_in': rwkv_w_in, 'rwkv_mu': rwkv_mu, 'rwkv_w0': rwkv_w0,
            'rwkv_w_w2': rwkv_w_w2, 'rwkv_a0': rwkv_a0, 'rwkv_w_a2': rwkv_w_a2,
            'rwkv_k_k': rwkv_k_k, 'rwkv_k_a': rwkv_k_a, 'rwkv_r_k': rwkv_r_k,
            'rwkv_ln_g': rwkv_ln_g, 'rwkv_ln_b': rwkv_ln_b, 'rwkv_w_out': rwkv_w_out,
            'final_g': final_g}


def reference(x, positions, norm_g, mla_w_in, mla_q_norm, mla_w_uq, mla_kv_norm, mla_w_ukv,
              mla_w_out, rwkv_w_in, rwkv_mu, rwkv_w0, rwkv_w_w2, rwkv_a0, rwkv_w_a2,
              rwkv_k_k, rwkv_k_a, rwkv_r_k, rwkv_ln_g, rwkv_ln_b, rwkv_w_out, final_g):
    for i in range(DEPTH):
        h = rms_norm(x, norm_g[i])
        j = i // N_MIXERS
        if i % N_MIXERS == 0:
            x = x + mla_mixer(h, positions, mla_w_in[j], mla_q_norm[j], mla_w_uq[j],
                              mla_kv_norm[j], mla_w_ukv[j], mla_w_out[j])
        else:
            x = x + rwkv7_mixer(h, rwkv_w_in[j], rwkv_mu[j], rwkv_w0[j], rwkv_w_w2[j],
                                rwkv_a0[j], rwkv_w_a2[j], rwkv_k_k[j], rwkv_k_a[j],
                                rwkv_r_k[j], rwkv_ln_g[j], rwkv_ln_b[j], rwkv_w_out[j])
    return rms_norm(x, final_g)
```

```cpp
#include <hip/hip_runtime.h>
#include <hip/hip_cooperative_groups.h>
#include <cstdio>
#include <cstdint>
#include <cmath>
namespace cg = cooperative_groups;
namespace pg8 {
#define PG8_LAS __attribute__((address_space(3)))
typedef unsigned short bf16_t;
typedef short bf16x8 __attribute__((ext_vector_type(8)));
typedef float f32x4 __attribute__((ext_vector_type(4)));
typedef unsigned u32x4 __attribute__((ext_vector_type(4)));
constexpr int BM = 256, BK = 64, HALF = 128, HTB = HALF * BK * 2  , STAGE_BYTES = 8 * HTB, NXCD = 8, WGM = 8;

__host__ __device__ __forceinline__ int lds_byte(int r, int c) { const int st = (r >> 4) * 2 + (c >> 5), rr = r & 15, cc = c & 31, ob = rr * 64 + cc * 2; return st * 1024 + (ob ^ (((ob >> 9) & 1) << 5)); }
__host__ __device__ __forceinline__ void stage_rc(int b, int& R, int& C) { const int st = b / 1024, sb = b % 1024, swz = sb ^ (((sb >> 9) & 1) << 5); R = (st >> 1) * 16 + swz / 64; C = (st & 1) * 32 + (swz % 64) / 2; }
__host__ __device__ __forceinline__ int perm32(int rho) { const int n = rho >> 4, i = rho & 15; return 8 * (i >> 2) + 4 * n + (i & 3); }

struct Unit { int pm, pn; };
struct Gemm { const bf16_t* A; const bf16_t* Bt; int M, N, K; };

struct StaticOrder {
    int nM, nN, nwg, G, c;
    __host__ __device__ void init(int M, int N, int G_, int c_) { nM = M / BM; nN = N / BM; nwg = nM * nN; G = G_; c = c_; }
    __host__ __device__ bool next(int i, Unit& u) const {
        const long L = (long)i * G + c; if (L >= nwg) return false;
        int wgid = (int)L; { const int q = nwg / NXCD, r = nwg % NXCD, xcd = wgid % NXCD, off = wgid / NXCD; wgid = (xcd < r ? xcd * (q + 1) : r * (q + 1) + (xcd - r) * q) + off; }
        const int nig = WGM * nN, gid = wgid / nig, fm = gid * WGM, gsz = (nM - fm) < WGM ? (nM - fm) : WGM;
        u.pm = fm + ((wgid % nig) % gsz); u.pn = (wgid % nig) / gsz; return true;
    }
    __device__ __forceinline__ void a_ready(const Unit&) const {}
    __device__ __forceinline__ void done(const Unit&) const {}
};

__device__ __forceinline__ unsigned cvt_pk_bf16(float lo, float hi) { unsigned r; asm volatile("v_cvt_pk_bf16_f32 %0, %1, %2" : "=v"(r) : "v"(lo), "v"(hi)); return r; }
typedef float f32x2 __attribute__((ext_vector_type(2)));
template <class Epi, class Sched, bool ALIGN_EPI = false, bool SP2 = false>
__device__ __forceinline__ void gemm_phase(PG8_LAS unsigned char* lds, const Gemm g, const Sched& S, const Epi& E) {
    int tid_ = threadIdx.x; asm volatile("" : "+v"(tid_));
    const int tid = tid_, wid = __builtin_amdgcn_readfirstlane(tid >> 6), lane = tid & 63, wr = wid >> 2, wc = wid & 3, fr = lane & 15, fq = lane >> 4;
    const int K = g.K, nt = K / BK;
    unsigned voffA[2], voffB[2];
#pragma unroll
    for (int i = 0; i < 2; ++i) { int R, C; stage_rc(tid * 16 + i * 8192, R, C); const int Rb = Epi::PERM ? ((R & ~31) + perm32(R & 31)) : R;
        voffA[i] = (unsigned)(R * K + C) * 2u; voffB[i] = (unsigned)(Rb * K + C) * 2u; }
    const size_t kstep = (size_t)(BK * 2);
    const size_t hstep = (size_t)HALF * K * 2;
    const size_t tstep = 2 * hstep;
    const unsigned ldsw = (unsigned)wid * 1024u;
    const int aoff = lds_byte(wr * 64 + fr, fq * 8), boff = lds_byte(wc * 32 + fr, fq * 8);
#define PG8_SA(b, h) (((b) * 2 + (h)) * HTB)
#define PG8_SB(b, h) ((4 + (b) * 2 + (h)) * HTB)
#define PG8_STAGE(bufoff, gbase, voff) do { _Pragma("unroll") for (int _i = 0; _i < 2; ++_i) \
        __builtin_amdgcn_global_load_lds((const unsigned*)((const char*)(gbase) + (voff)[_i]), (PG8_LAS unsigned*)(lds + (bufoff) + ldsw + _i * 8192), 16, 0, 0); } while (0)
#define PG8_LDA(dst, b, h) do { _Pragma("unroll") for (int m = 0; m < 4; ++m) _Pragma("unroll") for (int k = 0; k < 2; ++k) dst[m][k] = *(const PG8_LAS bf16x8*)(lds + PG8_SA(b, h) + aoff + m * 2048 + k * 1024); } while (0)
#define PG8_LDB(dst, b, h) do { _Pragma("unroll") for (int n = 0; n < 2; ++n) _Pragma("unroll") for (int k = 0; k < 2; ++k) dst[n][k] = *(const PG8_LAS bf16x8*)(lds + PG8_SB(b, h) + boff + n * 2048 + k * 1024); } while (0)
#define PG8_MMA(ai, bj, At, Bt) do { __builtin_amdgcn_s_setprio(1); _Pragma("unroll") for (int m = 0; m < 4; ++m) _Pragma("unroll") for (int n = 0; n < 2; ++n) _Pragma("unroll") for (int k = 0; k < 2; ++k) \
        acc[ai][bj][m][n] = __builtin_amdgcn_mfma_f32_16x16x32_bf16(Bt[n][k], At[m][k], acc[ai][bj][m][n], 0, 0, 0); __builtin_amdgcn_s_setprio(0); } while (0)
#define PG8_WAIT_V(n) asm volatile("s_waitcnt vmcnt(" #n ")" ::: "memory")
#define PG8_WAIT_L(n) asm volatile("s_waitcnt lgkmcnt(" #n ")" ::: "memory")
#define PG8_BAR __builtin_amdgcn_s_barrier()
#define PG8_SCHED __builtin_amdgcn_sched_barrier(0)
    Unit cur, nxt; int ui = 0;
    if (!S.next(0, cur)) return;
    f32x4 acc[2][2][4][2];
#pragma unroll
    for (int a = 0; a < 2; ++a)
#pragma unroll
        for (int b = 0; b < 2; ++b)
#pragma unroll
            for (int m = 0; m < 4; ++m)
#pragma unroll
                for (int n = 0; n < 2; ++n) acc[a][b][m][n] = (f32x4){0.f, 0.f, 0.f, 0.f};
    bf16x8 At[4][2], B0[2][2], B1[2][2];
    const char* cA = (const char*)g.A + (size_t)cur.pm * tstep; const char* cB = (const char*)g.Bt + (size_t)cur.pn * tstep;
    S.a_ready(cur);
    if constexpr (SP2) {
        PG8_STAGE(PG8_SB(0, 0), cB, voffB); PG8_STAGE(PG8_SB(0, 1), cB + hstep, voffB); PG8_STAGE(PG8_SA(0, 0), cA, voffA); PG8_STAGE(PG8_SA(0, 1), cA + hstep, voffA);
        if (wr == 1) PG8_BAR;
        PG8_WAIT_V(2); PG8_BAR;
        PG8_STAGE(PG8_SB(1, 0), cB + kstep, voffB); PG8_STAGE(PG8_SA(1, 0), cA + kstep, voffA); PG8_STAGE(PG8_SB(1, 1), cB + hstep + kstep, voffB);
        PG8_WAIT_V(6); PG8_BAR;
    } else {
        PG8_STAGE(PG8_SB(0, 0), cB, voffB); PG8_STAGE(PG8_SA(0, 0), cA, voffA); PG8_STAGE(PG8_SB(0, 1), cB + hstep, voffB); PG8_STAGE(PG8_SA(0, 1), cA + hstep, voffA);
        if (wr == 1) PG8_BAR;
        PG8_WAIT_V(4); PG8_BAR;
        PG8_STAGE(PG8_SB(1, 0), cB + kstep, voffB); PG8_STAGE(PG8_SA(1, 0), cA + kstep, voffA); PG8_STAGE(PG8_SB(1, 1), cB + hstep + kstep, voffB);
        PG8_WAIT_V(6); PG8_BAR;
    }
    for (;;) {
        const bool has_next = S.next(ui + 1, nxt);
        const char* nA = has_next ? (const char*)g.A + (size_t)nxt.pm * tstep : cA; const char* nB = has_next ? (const char*)g.Bt + (size_t)nxt.pn * tstep : cB;
        for (int t = 0; t < nt; t += 2) {
            const bool last = (t == nt - 2);
            const char* a1 = cA + (size_t)(t + 1) * kstep;
            const char* a2 = last ? nA : cA + (size_t)(t + 2) * kstep; const char* b2 = last ? nB : cB + (size_t)(t + 2) * kstep;
            const char* a3 = a2 + kstep; const char* b3 = b2 + kstep;
            if (last && has_next) S.a_ready(nxt);
            if constexpr (SP2) {
            PG8_LDB(B0, 0, 0); PG8_LDB(B1, 0, 1); PG8_SCHED; PG8_LDA(At, 0, 0); PG8_STAGE(PG8_SA(1, 1), a1 + hstep, voffA);
            PG8_WAIT_V(8); PG8_WAIT_L(0); PG8_BAR; PG8_MMA(0, 0, At, B0); PG8_MMA(0, 1, At, B1); PG8_BAR; PG8_SCHED;
            PG8_LDA(At, 0, 1); PG8_STAGE(PG8_SB(0, 0), b2, voffB); PG8_STAGE(PG8_SB(0, 1), b2 + hstep, voffB); PG8_STAGE(PG8_SA(0, 0), a2, voffA);
            PG8_WAIT_V(8); PG8_WAIT_L(0); PG8_BAR; PG8_MMA(1, 0, At, B0); PG8_MMA(1, 1, At, B1); PG8_BAR; PG8_SCHED;
            PG8_LDB(B0, 1, 0); PG8_LDB(B1, 1, 1); PG8_SCHED; PG8_LDA(At, 1, 0); PG8_STAGE(PG8_SA(0, 1), a2 + hstep, voffA);
            PG8_WAIT_V(8); PG8_WAIT_L(0); PG8_BAR; PG8_MMA(0, 0, At, B0); PG8_MMA(0, 1, At, B1); PG8_BAR; PG8_SCHED;
            PG8_LDA(At, 1, 1); PG8_STAGE(PG8_SB(1, 0), b3, voffB); PG8_STAGE(PG8_SB(1, 1), b3 + hstep, voffB); PG8_STAGE(PG8_SA(1, 0), a3, voffA);
            PG8_WAIT_V(8); PG8_WAIT_L(0); PG8_BAR; PG8_MMA(1, 0, At, B0); PG8_MMA(1, 1, At, B1); PG8_BAR; PG8_SCHED;
            } else {
            PG8_LDB(B0, 0, 0); PG8_SCHED; PG8_LDA(At, 0, 0); PG8_STAGE(PG8_SA(1, 1), a1 + hstep, voffA);
            PG8_WAIT_L(8); PG8_BAR; PG8_WAIT_L(0); PG8_MMA(0, 0, At, B0); PG8_BAR; PG8_SCHED;
            PG8_LDB(B1, 0, 1); PG8_STAGE(PG8_SB(0, 0), b2, voffB);
            PG8_BAR; PG8_WAIT_L(0); PG8_MMA(0, 1, At, B1); PG8_BAR;
            PG8_LDA(At, 0, 1); PG8_STAGE(PG8_SA(0, 0), a2, voffA);
            PG8_BAR; PG8_WAIT_L(0); PG8_MMA(1, 0, At, B0); PG8_BAR; PG8_SCHED;
            PG8_STAGE(PG8_SB(0, 1), b2 + hstep, voffB);
            PG8_WAIT_V(6); PG8_BAR; PG8_MMA(1, 1, At, B1); PG8_BAR;
            PG8_LDB(B0, 1, 0); PG8_SCHED; PG8_LDA(At, 1, 0); PG8_STAGE(PG8_SA(0, 1), a2 + hstep, voffA);
            PG8_WAIT_L(8); PG8_BAR; PG8_WAIT_L(0); PG8_MMA(0, 0, At, B0); PG8_BAR; PG8_SCHED;
            PG8_LDB(B1, 1, 1); PG8_STAGE(PG8_SB(1, 0), b3, voffB);
            PG8_BAR; PG8_WAIT_L(0); PG8_MMA(0, 1, At, B1); PG8_BAR;
            PG8_LDA(At, 1, 1); PG8_STAGE(PG8_SA(1, 0), a3, voffA);
            PG8_BAR; PG8_WAIT_L(0); PG8_MMA(1, 0, At, B0); PG8_BAR; PG8_SCHED;
            PG8_STAGE(PG8_SB(1, 1), b3 + hstep, voffB);
            PG8_WAIT_V(6); PG8_BAR; PG8_MMA(1, 1, At, B1); PG8_BAR;
            }
        }
        if constexpr (ALIGN_EPI) { if (wr == 0) PG8_BAR; }
        if constexpr (!Epi::AFTER_DRAIN) { E(acc, cur, wr, wc, fr, fq); S.done(cur); }
        if (!has_next) break;
#pragma unroll
        for (int a = 0; a < 2; ++a)
#pragma unroll
            for (int b = 0; b < 2; ++b)
#pragma unroll
                for (int m = 0; m < 4; ++m)
#pragma unroll
                    for (int n = 0; n < 2; ++n) acc[a][b][m][n] = (f32x4){0.f, 0.f, 0.f, 0.f};
        cur = nxt; cA = nA; cB = nB; ++ui;
        if constexpr (ALIGN_EPI) { if (wr == 1) PG8_BAR; }
    }
    PG8_WAIT_V(0);
    if constexpr (!ALIGN_EPI) { if (wr == 0) PG8_BAR; }
    PG8_BAR;
    if constexpr (Epi::AFTER_DRAIN) { E.fused(acc, cur, wr, wc, fr, fq, lds, wid, lane); S.done(cur); }
#undef PG8_SA
#undef PG8_SB
#undef PG8_STAGE
#undef PG8_LDA
#undef PG8_LDB
#undef PG8_MMA
#undef PG8_WAIT_V
#undef PG8_WAIT_L
#undef PG8_BAR
#undef PG8_SCHED
}
}

typedef pg8::bf16_t bf16_t;
typedef pg8::f32x4 f32x4;
typedef pg8::u32x4 u32x4;
typedef float f32x2 __attribute__((ext_vector_type(2)));
typedef float f32x16 __attribute__((ext_vector_type(16)));
typedef short bf16x8 __attribute__((ext_vector_type(8)));
typedef short s16x4 __attribute__((ext_vector_type(4)));
typedef _Float16 h16x2 __attribute__((ext_vector_type(2)));

constexpr int BATCH = 8, SEQ = 8192, DM = 1024, T = BATCH * SEQ;
constexpr float NORM_EPS = 1e-6f, GN_EPS = 64e-5f;
constexpr size_t MiB = 1u << 20;
constexpr size_t WS_SSQ = 44 * MiB;
constexpr size_t WS_W = 2 * MiB;
constexpr size_t SZ_MWIN = 2304u * 1024 * 2, SZ_MWUQ = 1536u * 768 * 2, SZ_MWUKV = 2048u * 256 * 2, SZ_WOUT = 1024u * 1024 * 2;
constexpr size_t SZ_MLA = SZ_MWIN + SZ_MWUQ + SZ_MWUKV + SZ_WOUT;
constexpr size_t SZ_RWIN = 4352u * 1024 * 2, SZ_RWL = 2048u * 128 * 2;
constexpr size_t SZ_RWKV = SZ_RWIN + SZ_RWL + SZ_WOUT;
static_assert(WS_W + 2 * SZ_MLA + 2 * SZ_RWKV <= 48 * MiB, "weights");
constexpr size_t WS_BUFA = 48 * MiB;
constexpr size_t WS_L = 176 * MiB;
constexpr size_t WS_QLAT = WS_L, WS_KVLAT = WS_L + 96 * MiB, WS_KROPE = WS_L + 128 * MiB, WS_GATE = WS_L + 136 * MiB, WS_Q = WS_L + 264 * MiB,
                 WS_KN = WS_L + 456 * MiB, WS_V = WS_L + 584 * MiB;
constexpr size_t WS_PR = WS_L, WS_LARAW = WS_L + 512 * MiB, WS_LA = WS_L + 544 * MiB, WS_E = WS_L + 560 * MiB, WS_A = WS_L + 688 * MiB;
constexpr size_t WS_SSX = WS_L + 816 * MiB;
constexpr size_t WS_END = WS_SSX + 4 * MiB;
constexpr size_t WS_XF = WS_PR;

constexpr int LDS_BYTES = 131072 + 1024;
constexpr int LDS_MISC = 131072;
constexpr size_t WS_BAR = 0, BAR_BYTES = 16384;
constexpr int NTHREADS = 512;

__device__ const float ROPE_INVF[32] = {
    1.000000000e+00f, 7.498942018e-01f, 5.623413324e-01f, 4.216965139e-01f, 3.162277639e-01f, 2.371373922e-01f, 1.778279394e-01f, 1.333521456e-01f,
    1.000000015e-01f, 7.498941571e-02f, 5.623412877e-02f, 4.216964915e-02f, 3.162277862e-02f, 2.371373586e-02f, 1.778279431e-02f, 1.333521493e-02f,
    9.999999776e-03f, 7.498942316e-03f, 5.623413250e-03f, 4.216964822e-03f, 3.162277862e-03f, 2.371373819e-03f, 1.778279431e-03f, 1.333521446e-03f,
    1.000000047e-03f, 7.498941850e-04f, 5.623413017e-04f, 4.216965463e-04f, 3.162277862e-04f, 2.371373848e-04f, 1.778279402e-04f, 1.333521504e-04f};

__device__ __forceinline__ unsigned cvtpk(float lo, float hi) { return pg8::cvt_pk_bf16(lo, hi); }
__device__ __forceinline__ u32x4 pack8bf(f32x4 a, f32x4 b) { u32x4 w; w.x = cvtpk(a[0], a[1]); w.y = cvtpk(a[2], a[3]); w.z = cvtpk(b[0], b[1]); w.w = cvtpk(b[2], b[3]); return w; }
__device__ __forceinline__ unsigned pkh(float lo, float hi) { h16x2 v = {(_Float16)lo, (_Float16)hi}; return __builtin_bit_cast(unsigned, v); }
__device__ __forceinline__ u32x4 pack8h(f32x4 a, f32x4 b) { u32x4 w; w.x = pkh(a[0], a[1]); w.y = pkh(a[2], a[3]); w.z = pkh(b[0], b[1]); w.w = pkh(b[2], b[3]); return w; }
__device__ __forceinline__ float bf_lo(unsigned w) { return __uint_as_float(w << 16); }
__device__ __forceinline__ float bf_hi(unsigned w) { return __uint_as_float(w & 0xffff0000u); }
__device__ __forceinline__ void unpack8bf(u32x4 w, float* f) { f[0] = bf_lo(w.x); f[1] = bf_hi(w.x); f[2] = bf_lo(w.y); f[3] = bf_hi(w.y); f[4] = bf_lo(w.z); f[5] = bf_hi(w.z); f[6] = bf_lo(w.w); f[7] = bf_hi(w.w); }
__device__ __forceinline__ float h_lo(unsigned w) { return (float)__builtin_bit_cast(_Float16, (unsigned short)(w & 0xffffu)); }
__device__ __forceinline__ float h_hi(unsigned w) { return (float)__builtin_bit_cast(_Float16, (unsigned short)(w >> 16)); }
__device__ __forceinline__ void unpack8h(u32x4 w, float* f) { f[0] = h_lo(w.x); f[1] = h_hi(w.x); f[2] = h_lo(w.y); f[3] = h_hi(w.y); f[4] = h_lo(w.z); f[5] = h_hi(w.z); f[6] = h_lo(w.w); f[7] = h_hi(w.w); }
__device__ __forceinline__ float sigmoidf_(float z) { return __builtin_amdgcn_rcpf(1.f + __expf(-z)); }
__device__ __forceinline__ float siluf_(float z) { return z * sigmoidf_(z); }
__device__ __forceinline__ float wave_sum(float v) {
#pragma unroll
    for (int o = 1; o < 64; o <<= 1) v += __shfl_xor(v, o);
    return v;
}
__device__ __forceinline__ void rope_sc(int pos, int i, float& s, float& c) {
    const float ang = (float)pos * ROPE_INVF[i];
    double rev = (double)ang * 0.15915494309189535;
    rev -= __builtin_floor(rev);
    const float fr = (float)rev;
    s = __builtin_amdgcn_sinf(fr); c = __builtin_amdgcn_cosf(fr);
}
__device__ __forceinline__ void rope8(f32x4& v0, f32x4& v1, int pos, int i0) {
    float s, c, a, b;
    rope_sc(pos, i0, s, c);     a = v0[0]; b = v0[1]; v0[0] = a * c - b * s; v0[1] = b * c + a * s;
    rope_sc(pos, i0 + 1, s, c); a = v0[2]; b = v0[3]; v0[2] = a * c - b * s; v0[3] = b * c + a * s;
    rope_sc(pos, i0 + 2, s, c); a = v1[0]; b = v1[1]; v1[0] = a * c - b * s; v1[1] = b * c + a * s;
    rope_sc(pos, i0 + 3, s, c); a = v1[2]; b = v1[3]; v1[2] = a * c - b * s; v1[3] = b * c + a * s;
}

namespace pg8 {
__device__ __forceinline__ float row_rstd(const float* ssx, int row) {
    const f32x4 s0 = *(const f32x4*)(ssx + (size_t)row * 16), s1 = *(const f32x4*)(ssx + (size_t)row * 16 + 4), s2 = *(const f32x4*)(ssx + (size_t)row * 16 + 8), s3 = *(const f32x4*)(ssx + (size_t)row * 16 + 12);
    const float t = (((s0[0] + s0[1]) + (s0[2] + s0[3])) + ((s1[0] + s1[1]) + (s1[2] + s1[3]))) + (((s2[0] + s2[1]) + (s2[2] + s2[3])) + ((s3[0] + s3[1]) + (s3[2] + s3[3])));
    return 1.0f / sqrtf(t * (1.0f / 1024.0f) + NORM_EPS);
}
struct EpiMlaIn {
    static constexpr bool PERM = true, AFTER_DRAIN = false;
    unsigned char* ws; const int* pos;
    __device__ __forceinline__ void operator()(const f32x4 (&acc)[2][2][4][2], const Unit& u, int wr, int wc, int fr, int fq) const {
        const int ct = u.pn; const int row0 = u.pm * BM + wr * 64 + fr;
        bf16_t* qlat = (bf16_t*)(ws + WS_QLAT); bf16_t* kvlat = (bf16_t*)(ws + WS_KVLAT); bf16_t* krope = (bf16_t*)(ws + WS_KROPE); bf16_t* gate = (bf16_t*)(ws + WS_GATE); float* ssq = (float*)(ws + WS_SSQ);
#pragma unroll
        for (int ai = 0; ai < 2; ++ai)
#pragma unroll
            for (int m = 0; m < 4; ++m) {
                const int row = row0 + ai * HALF + m * 16;
                const float rs = row_rstd((const float*)(ws + WS_SSX), row);
                if (ct <= 3) {
                    float s = 0.f;
#pragma unroll
                    for (int bj = 0; bj < 2; ++bj) { const f32x4 v0 = acc[ai][bj][m][0] * rs, v1 = acc[ai][bj][m][1] * rs; const int cc = bj * HALF + wc * 32 + 8 * fq;
                        s += (v0[0] * v0[0] + v0[1] * v0[1]) + (v0[2] * v0[2] + v0[3] * v0[3]) + (v1[0] * v1[0] + v1[1] * v1[1]) + (v1[2] * v1[2] + v1[3] * v1[3]);
                        if (ct < 3) *(u32x4*)(qlat + (size_t)row * 768 + ct * 256 + cc) = pack8bf(v0, v1);
                        else *(u32x4*)(kvlat + (size_t)row * 256 + cc) = pack8bf(v0, v1); }
                    s += __shfl_xor(s, 16); s += __shfl_xor(s, 32);
                    if (fq == 0) ssq[(size_t)row * 16 + ct * 4 + wc] = s;
                } else if (ct == 4) {
                    if (wc < 2) { f32x4 v0 = acc[ai][0][m][0] * rs, v1 = acc[ai][0][m][1] * rs; const int cc = wc * 32 + 8 * fq;
                        rope8(v0, v1, pos[row], cc >> 1);
                        *(u32x4*)(krope + (size_t)row * 64 + cc) = pack8bf(v0, v1); }
                } else {
#pragma unroll
                    for (int bj = 0; bj < 2; ++bj) { f32x4 v0 = acc[ai][bj][m][0] * rs, v1 = acc[ai][bj][m][1] * rs; const int cc = bj * HALF + wc * 32 + 8 * fq;
#pragma unroll
                        for (int e = 0; e < 4; ++e) { v0[e] = siluf_(v0[e]); v1[e] = siluf_(v1[e]); }
                        *(u32x4*)(gate + (size_t)row * 1024 + (ct - 5) * 256 + cc) = pack8bf(v0, v1); }
                }
            }
    }
};
struct EpiUq {
    static constexpr bool PERM = true, AFTER_DRAIN = false;
    unsigned char* ws; const int* pos;
    __device__ __forceinline__ void operator()(const f32x4 (&acc)[2][2][4][2], const Unit& u, int wr, int wc, int fr, int fq) const {
        const int ct = u.pn; const int row0 = u.pm * BM + wr * 64 + fr; bf16_t* q = (bf16_t*)(ws + WS_Q); const float* ssq = (const float*)(ws + WS_SSQ);
#pragma unroll
        for (int ai = 0; ai < 2; ++ai)
#pragma unroll
            for (int m = 0; m < 4; ++m) {
                const int row = row0 + ai * HALF + m * 16;
                float ssum;
                { const f32x4 s0 = *(const f32x4*)(ssq + (size_t)row * 16), s1 = *(const f32x4*)(ssq + (size_t)row * 16 + 4), s2 = *(const f32x4*)(ssq + (size_t)row * 16 + 8);
                  ssum = (((s0[0] + s0[1]) + (s0[2] + s0[3])) + ((s1[0] + s1[1]) + (s1[2] + s1[3]))) + ((s2[0] + s2[1]) + (s2[2] + s2[3])); }
                const float rs = 1.0f / sqrtf(ssum * (1.0f / 768.0f) + NORM_EPS);
                int ps = 0; if (ct >= 4) ps = pos[row];
#pragma unroll
                for (int bj = 0; bj < 2; ++bj) { f32x4 v0 = acc[ai][bj][m][0] * rs, v1 = acc[ai][bj][m][1] * rs; const int cc = bj * HALF + wc * 32 + 8 * fq;
                    if (ct < 4) { const int col = ct * 256 + cc, h = col >> 7, d = col & 127;
                        *(u32x4*)(q + (size_t)row * 1536 + h * 192 + d) = pack8bf(v0, v1); }
                    else { const int col = (ct - 4) * 256 + cc, h = col >> 6, p = col & 63;
                        rope8(v0, v1, ps, p >> 1);
                        *(u32x4*)(q + (size_t)row * 1536 + h * 192 + 128 + p) = pack8bf(v0, v1); } }
            }
    }
};
struct EpiUkv {
    static constexpr bool PERM = true, AFTER_DRAIN = false;
    unsigned char* ws;
    __device__ __forceinline__ void operator()(const f32x4 (&acc)[2][2][4][2], const Unit& u, int wr, int wc, int fr, int fq) const {
        const int row0 = u.pm * BM + wr * 64 + fr; bf16_t* kn = (bf16_t*)(ws + WS_KN); bf16_t* v = (bf16_t*)(ws + WS_V); const float* ssq = (const float*)(ws + WS_SSQ);
#pragma unroll
        for (int ai = 0; ai < 2; ++ai)
#pragma unroll
            for (int m = 0; m < 4; ++m) {
                const int row = row0 + ai * HALF + m * 16;
                const f32x4 s3 = *(const f32x4*)(ssq + (size_t)row * 16 + 12);
                const float rs = 1.0f / sqrtf(((s3[0] + s3[1]) + (s3[2] + s3[3])) * (1.0f / 256.0f) + NORM_EPS);
                const size_t off = (size_t)row * 1024 + u.pn * 128 + wc * 32 + 8 * fq;
                *(u32x4*)(kn + off) = pack8bf(acc[ai][0][m][0] * rs, acc[ai][0][m][1] * rs);
                *(u32x4*)(v + off) = pack8bf(acc[ai][1][m][0] * rs, acc[ai][1][m][1] * rs);
            }
    }
};
struct EpiResid {
    static constexpr bool PERM = true, AFTER_DRAIN = false;
    bf16_t* xb; float* ssx; float* xf;
    __device__ __forceinline__ void operator()(const f32x4 (&acc)[2][2][4][2], const Unit& u, int wr, int wc, int fr, int fq) const {
        const int row0 = u.pm * BM + wr * 64 + fr;
#pragma unroll
        for (int ai = 0; ai < 2; ++ai)
#pragma unroll
            for (int m = 0; m < 4; ++m) { const int row = row0 + ai * HALF + m * 16; float s = 0.f;
#pragma unroll
                for (int bj = 0; bj < 2; ++bj) { const size_t off = (size_t)row * DM + u.pn * BM + bj * HALF + wc * 32 + 8 * fq;
                    const u32x4 xw = *(const u32x4*)(xb + off);
                    f32x4 v0 = acc[ai][bj][m][0], v1 = acc[ai][bj][m][1];
                    v0[0] += bf_lo(xw.x); v0[1] += bf_hi(xw.x); v0[2] += bf_lo(xw.y); v0[3] += bf_hi(xw.y); v1[0] += bf_lo(xw.z); v1[1] += bf_hi(xw.z); v1[2] += bf_lo(xw.w); v1[3] += bf_hi(xw.w);
                    if (xf) { *(f32x4*)(xf + off) = v0; *(f32x4*)(xf + off + 4) = v1; }
                    else { const u32x4 ow = pack8bf(v0, v1); *(u32x4*)(xb + off) = ow;
                        const float a0 = bf_lo(ow.x), a1 = bf_hi(ow.x), a2 = bf_lo(ow.y), a3 = bf_hi(ow.y), a4 = bf_lo(ow.z), a5 = bf_hi(ow.z), a6 = bf_lo(ow.w), a7 = bf_hi(ow.w);
                        s += ((a0 * a0 + a1 * a1) + (a2 * a2 + a3 * a3)) + ((a4 * a4 + a5 * a5) + (a6 * a6 + a7 * a7)); } }
                if (!xf) { s += __shfl_xor(s, 16); s += __shfl_xor(s, 32); if (fq == 0) ssx[(size_t)row * 16 + u.pn * 4 + wc] = s; } }
    }
};
struct EpiRwkvIn {
    static constexpr bool PERM = true, AFTER_DRAIN = false;
    unsigned char* ws;
    __device__ __forceinline__ void operator()(const f32x4 (&acc)[2][2][4][2], const Unit& u, int wr, int wc, int fr, int fq) const {
        const int ct = u.pn; const int row0 = u.pm * BM + wr * 64 + fr; bf16_t* pr = (bf16_t*)(ws + WS_PR); float* laraw = (float*)(ws + WS_LARAW);
#pragma unroll
        for (int ai = 0; ai < 2; ++ai)
#pragma unroll
            for (int m = 0; m < 4; ++m) {
                const int row = row0 + ai * HALF + m * 16;
                const float rs = row_rstd((const float*)(ws + WS_SSX), row);
                if (ct < 16) {
#pragma unroll
                    for (int bj = 0; bj < 2; ++bj) { const int cc = bj * HALF + wc * 32 + 8 * fq; *(u32x4*)(pr + (size_t)row * 4096 + ct * 256 + cc) = pack8bf(acc[ai][bj][m][0] * rs, acc[ai][bj][m][1] * rs); }
                } else { const int cc = wc * 32 + 8 * fq; float* d = laraw + (size_t)row * 128 + cc; *(f32x4*)d = acc[ai][0][m][0] * rs; *(f32x4*)(d + 4) = acc[ai][0][m][1] * rs; }
            }
    }
};
struct EpiLora {
    static constexpr bool PERM = true, AFTER_DRAIN = false;
    unsigned char* ws; const float* w0; const float* a0;
    __device__ __forceinline__ void operator()(const f32x4 (&acc)[2][2][4][2], const Unit& u, int wr, int wc, int fr, int fq) const {
        const int ct = u.pn; const int row0 = u.pm * BM + wr * 64 + fr; _Float16* E = (_Float16*)(ws + WS_E); _Float16* A = (_Float16*)(ws + WS_A);
        const bool isw = ct < 4; const float* bias = isw ? w0 : a0; _Float16* dst = isw ? E : A; const float mul = isw ? 0.6065306597126334f : 1.0f;
        const int cb = (isw ? ct : ct - 4) * 256 + wc * 32 + 8 * fq;
#pragma unroll
        for (int bj = 0; bj < 2; ++bj) { const int c = cb + bj * HALF;
            const f32x4 b0 = *(const f32x4*)(bias + c), b1 = *(const f32x4*)(bias + c + 4);
#pragma unroll
            for (int ai = 0; ai < 2; ++ai)
#pragma unroll
                for (int m = 0; m < 4; ++m) { const int row = row0 + ai * HALF + m * 16;
                    f32x4 v0 = acc[ai][bj][m][0] + b0, v1 = acc[ai][bj][m][1] + b1;
#pragma unroll
                    for (int e = 0; e < 4; ++e) { v0[e] = sigmoidf_(v0[e]) * mul; v1[e] = sigmoidf_(v1[e]) * mul; }
                    *(u32x4*)(dst + (size_t)row * 1024 + c) = pack8h(v0, v1); } }
    }
};
}

#define LASF __attribute__((address_space(3)))
__device__ __forceinline__ int il64(int i) { return 2 * (i & 31) + (i >> 5); }
__device__ __forceinline__ int rowmap(int mode, int n) {
    if (mode == 1) return n < 1024 ? n : (n < 1088 ? 1024 + il64(n - 1024) : n + 192);
    if (mode == 2) { const int h = n / 192, w = n - h * 192; return w < 128 ? h * 128 + w : 1024 + h * 64 + il64(w - 128); }
    if (mode == 3) return n + 1024;
    return n;
}
__device__ __forceinline__ void transpose_item(const float* W, int N, bf16_t* WT, int ldk, float* scr, int item, int lane, const float* kscale, float gscale, int mode) {
    const int nblk = N / 32, kb = item / nblk, nb = item - kb * nblk, k0 = 64 * kb, n0 = 32 * nb;
#pragma unroll 8
    for (int i = 0; i < 32; ++i) { const int kk = 2 * i + (lane >> 5); const float sc = kscale ? kscale[k0 + kk] * gscale : gscale;
        scr[kk * 33 + (lane & 31)] = W[(size_t)(k0 + kk) * N + n0 + (lane & 31)] * sc; }
    asm volatile("s_waitcnt lgkmcnt(0)" ::: "memory");
    const int c = lane & 7;
#pragma unroll
    for (int j = 0; j < 4; ++j) { const int n = (lane >> 3) + 8 * j; const float* s = scr + (8 * c) * 33 + n;
        u32x4 o; o.x = cvtpk(s[0 * 33], s[1 * 33]); o.y = cvtpk(s[2 * 33], s[3 * 33]); o.z = cvtpk(s[4 * 33], s[5 * 33]); o.w = cvtpk(s[6 * 33], s[7 * 33]);
        *(u32x4*)(WT + (size_t)rowmap(mode, n0 + n) * ldk + k0 + 8 * c) = o; }
    asm volatile("s_waitcnt lgkmcnt(0)" ::: "memory");
}
struct Args { const void* in[22]; float* out; unsigned char* ws; int ph_lo, ph_hi; };

template <class AP> __device__ __forceinline__ void prep_weights(AP ap, unsigned char* lds, int wave, int lane, int gw, int ngw) {
    float* scr = (float*)(lds + wave * 16384);
    constexpr int PER = 5088;
    const float QSCALE = 0.07216878364870322f * 1.4426950408889634f;
#pragma nounroll
    for (int it = gw; it < 2 * PER; it += ngw) {
        const int j = it / PER; int r = it - j * PER;
        unsigned char* mb = ap->ws + WS_W + (size_t)j * SZ_MLA; unsigned char* rb = ap->ws + WS_W + 2 * SZ_MLA + (size_t)j * SZ_RWKV;
        const float* W; int N; bf16_t* WT; int ldk; const float* ks = nullptr; float gs = 1.f; int mode = 0;
        if (r < 1056) { W = (const float*)ap->in[3] + (size_t)j * 1024 * 2112; N = 2112; WT = (bf16_t*)mb; ldk = 1024; ks = (const float*)ap->in[2] + (2 * j) * 1024; mode = 1; }
        else if ((r -= 1056) < 576) { W = (const float*)ap->in[5] + (size_t)j * 768 * 1536; N = 1536; WT = (bf16_t*)(mb + SZ_MWIN); ldk = 768; ks = (const float*)ap->in[4] + j * 768; gs = QSCALE; mode = 2; }
        else if ((r -= 576) < 256) { W = (const float*)ap->in[7] + (size_t)j * 256 * 2048; N = 2048; WT = (bf16_t*)(mb + SZ_MWIN + SZ_MWUQ); ldk = 256; ks = (const float*)ap->in[6] + j * 256; }
        else if ((r -= 256) < 512) { W = (const float*)ap->in[8] + (size_t)j * 1024 * 1024; N = 1024; WT = (bf16_t*)(mb + SZ_MWIN + SZ_MWUQ + SZ_MWUKV); ldk = 1024; }
        else if ((r -= 512) < 2112) { W = (const float*)ap->in[9] + (size_t)j * 1024 * 4224; N = 4224; WT = (bf16_t*)rb; ldk = 1024; ks = (const float*)ap->in[2] + (2 * j + 1) * 1024; }
        else if ((r -= 2112) < 32) { W = (const float*)ap->in[12] + (size_t)j * 64 * 1024; N = 1024; WT = (bf16_t*)(rb + SZ_RWIN); ldk = 128; }
        else if ((r -= 32) < 32) { W = (const float*)ap->in[14] + (size_t)j * 64 * 1024; N = 1024; WT = (bf16_t*)(rb + SZ_RWIN) + 64; ldk = 128; mode = 3; }
        else { r -= 32; W = (const float*)ap->in[20] + (size_t)j * 1024 * 1024; N = 1024; WT = (bf16_t*)(rb + SZ_RWIN + SZ_RWL); ldk = 1024; }
        transpose_item(W, N, WT, ldk, scr, r, lane, ks, gs, mode);
    }
    const int gt = gw * 64 + lane, ngt = ngw * 64;
    constexpr int Z0 = 24576, Z1 = 16384, Z2 = 16384, ZT = Z0 + Z1 + Z2;
    unsigned zz = 0u; asm volatile("" : "+v"(zz)); const u32x4 z = {zz, zz, zz, zz};
    for (int it = gt; it < 2 * ZT; it += ngt) {
        const int j = it / ZT; int r = it - j * ZT;
        unsigned char* mb = ap->ws + WS_W + (size_t)j * SZ_MLA; unsigned char* rb = ap->ws + WS_W + 2 * SZ_MLA + (size_t)j * SZ_RWKV;
        if (r < Z0) *(u32x4*)(mb + (size_t)1088 * 2048 + (size_t)r * 16) = z;
        else if ((r -= Z0) < Z1) *(u32x4*)(rb + (size_t)4224 * 2048 + (size_t)r * 16) = z;
        else { r -= Z1; const int row = r >> 3, u = r & 7; *(u32x4*)(rb + SZ_RWIN + (size_t)row * 256 + (row < 1024 ? 128 : 0) + u * 16) = z; }
    }
}

__device__ __forceinline__ void conv_rows_bf16(const float* X, bf16_t* XB, float* ssx, int gw, int ngw, int lane) {
    for (int m = gw; m < T; m += ngw) {
        const f32x4* xr = (const f32x4*)(X + (size_t)m * DM) + lane;
        unsigned long long* o8 = (unsigned long long*)(XB + (size_t)m * DM) + lane; float s = 0.f;
#pragma unroll
        for (int j = 0; j < 4; ++j) { const f32x4 v = xr[64 * j]; const unsigned w0 = cvtpk(v[0], v[1]), w1 = cvtpk(v[2], v[3]);
            const float a0 = bf_lo(w0), a1 = bf_hi(w0), a2 = bf_lo(w1), a3 = bf_hi(w1); s += (a0 * a0 + a1 * a1) + (a2 * a2 + a3 * a3);
            o8[64 * j] = (unsigned long long)w0 | ((unsigned long long)w1 << 32); }
        s = wave_sum(s);
        if (lane < 16) ssx[(size_t)m * 16 + lane] = lane == 0 ? s : 0.f;
    }
}
__device__ __forceinline__ void final_norm(const float* X, float* out, const float* g, int gw, int ngw, int lane) {
    f32x4 gv[4];
#pragma unroll
    for (int j = 0; j < 4; ++j) gv[j] = ((const f32x4*)g)[lane + 64 * j];
    for (int m = gw; m < T; m += ngw) {
        const f32x4* xr = (const f32x4*)(X + (size_t)m * DM) + lane; f32x4* orow = (f32x4*)(out + (size_t)m * DM) + lane;
        f32x4 v[4]; float s = 0.f;
#pragma unroll
        for (int j = 0; j < 4; ++j) { v[j] = xr[64 * j]; s += (v[j][0] * v[j][0] + v[j][1] * v[j][1]) + (v[j][2] * v[j][2] + v[j][3] * v[j][3]); }
        const float rstd = 1.0f / sqrtf(wave_sum(s) * (1.f / DM) + NORM_EPS);
#pragma unroll
        for (int j = 0; j < 4; ++j) orow[64 * j] = v[j] * rstd * gv[j];
    }
}

namespace att {
constexpr int KP = 400, KBUF = 64 * KP, VBUF = 16384;
constexpr int OFF_K = 0, OFF_V = 2 * KBUF, OFF_WS = OFF_V + 2 * VBUF, ATT_LDS = OFF_WS + 8 * 64 * 4;
static_assert(ATT_LDS <= 131072, "attention LDS");
constexpr float THR2 = 11.0f;
#define SBAR() __builtin_amdgcn_sched_barrier(0)
__device__ __forceinline__ int v_st(int k, int c) { const int kk = (k & ~0xC) | ((k & 4) << 1) | ((k & 8) >> 1); return ((kk >> 3) * 4 + (c >> 5)) * 512 + ((kk & 7) * 32 + (c & 31)) * 2; }
__device__ __forceinline__ int v_rd_base(int lane) { return ((lane & 3) << 3) | (((lane >> 2) & 3) << 6) | (((lane >> 4) & 1) << 5) | (((lane >> 5) & 1) << 8); }
constexpr int v_rd_off(int d0, int ks, int half) { return d0 * 512 + ks * 4096 + half * 2048; }
__device__ __forceinline__ int crow(int r, int hi) { return (r & 3) + 8 * (r >> 2) + 4 * hi; }

__device__ __forceinline__ void mask_tile(f32x16& p0, f32x16& p1, int dq) {
    const float NEG = -__builtin_inff();
#pragma unroll
    for (int r = 0; r < 16; ++r) {
        const int c = (r & 3) + 8 * (r >> 2);
        if (dq - c < 0) p0[r] = NEG;
        if (dq - c - 32 < 0) p1[r] = NEG;
    }
}
__device__ __forceinline__ void softmax_tile(f32x16& p0, f32x16& p1, float& m_reg, float& l_reg, float& alpha, bf16x8& pa0, bf16x8& pa1, bf16x8& pa2, bf16x8& pa3) {
    float pmax = p0[0];
#pragma unroll
    for (int r = 1; r < 16; ++r) pmax = fmaxf(pmax, p0[r]);
#pragma unroll
    for (int r = 0; r < 16; ++r) pmax = fmaxf(pmax, p1[r]);
    { auto rr = __builtin_amdgcn_permlane32_swap(__float_as_uint(pmax), __float_as_uint(pmax), false, false);
      pmax = fmaxf(__uint_as_float(rr[0]), __uint_as_float(rr[1])); }
    float mn;
    if (__builtin_expect(__all((pmax - m_reg) <= THR2), 1)) { mn = m_reg; alpha = 1.f; }
    else { mn = fmaxf(m_reg, pmax); alpha = __builtin_amdgcn_exp2f(m_reg - mn); m_reg = mn; }
#pragma unroll
    for (int r = 0; r < 16; ++r) p0[r] = __builtin_amdgcn_exp2f(p0[r] - mn);
#pragma unroll
    for (int r = 0; r < 16; ++r) p1[r] = __builtin_amdgcn_exp2f(p1[r] - mn);
    f32x2 ps2 = {0.f, 0.f};
#pragma unroll
    for (int r = 0; r < 16; r += 2) { ps2 += (f32x2){p0[r], p0[r + 1]}; ps2 += (f32x2){p1[r], p1[r + 1]}; }
    float ps = ps2[0] + ps2[1];
    { auto rr = __builtin_amdgcn_permlane32_swap(__float_as_uint(ps), __float_as_uint(ps), false, false);
      ps = __uint_as_float(rr[0]) + __uint_as_float(rr[1]); }
    l_reg = l_reg * alpha + ps;
#define PK4(P, B_, OUT) do { unsigned a0 = cvtpk(P[B_+0], P[B_+1]), a1 = cvtpk(P[B_+2], P[B_+3]);                          \
        unsigned b0 = cvtpk(P[B_+4], P[B_+5]), b1 = cvtpk(P[B_+6], P[B_+7]);                                             \
        auto r0 = __builtin_amdgcn_permlane32_swap(a0, b0, false, false); auto r1 = __builtin_amdgcn_permlane32_swap(a1, b1, false, false); \
        u32x4 w = {r0[0], r1[0], r0[1], r1[1]}; OUT = *reinterpret_cast<bf16x8*>(&w); } while (0)
    PK4(p0, 0, pa0); PK4(p0, 8, pa1); PK4(p1, 0, pa2); PK4(p1, 8, pa3);
#undef PK4
}
template <int KB>
__device__ __forceinline__ void qkt(f32x16& p0, f32x16& p1, const char* K_lds, int r32, int hi, const bf16x8* qr) {
    p0 = f32x16{}; p1 = f32x16{};
    const int kaddr = (int)(uintptr_t)K_lds + r32 * KP + hi * 16;
    bf16x8 f0, f1, f2, f3;
#define KRD(dst, i) asm volatile("ds_read_b128 %0, %1 offset:%2" : "=v"(dst) : "v"(kaddr), "i"(KB * KBUF + ((i) >> 1) * 32 + ((i) & 1) * 32 * KP) : "memory")
#define KMM(f, i, W) do { asm volatile("s_waitcnt lgkmcnt(%1)" : "+v"(f) : "n"(W) : "memory"); \
        if ((i) & 1) p1 = __builtin_amdgcn_mfma_f32_32x32x16_bf16(f, qr[(i) >> 1], p1, 0, 0, 0); else p0 = __builtin_amdgcn_mfma_f32_32x32x16_bf16(f, qr[(i) >> 1], p0, 0, 0, 0); \
        if ((i) + 4 < 24) KRD(f, (i) + 4); } while (0)
    KRD(f0, 0); KRD(f1, 1); KRD(f2, 2); KRD(f3, 3);
    KMM(f0, 0, 3); KMM(f1, 1, 3); KMM(f2, 2, 3); KMM(f3, 3, 3); KMM(f0, 4, 3); KMM(f1, 5, 3); KMM(f2, 6, 3); KMM(f3, 7, 3);
    KMM(f0, 8, 3); KMM(f1, 9, 3); KMM(f2, 10, 3); KMM(f3, 11, 3); KMM(f0, 12, 3); KMM(f1, 13, 3); KMM(f2, 14, 3); KMM(f3, 15, 3);
    KMM(f0, 16, 3); KMM(f1, 17, 3); KMM(f2, 18, 3); KMM(f3, 19, 3); KMM(f0, 20, 3); KMM(f1, 21, 2); KMM(f2, 22, 1); KMM(f3, 23, 0);
#undef KMM
#undef KRD
}
template <int VB>
__device__ __forceinline__ void pv_tile(f32x16* o, int vb0, bf16x8 pa0, bf16x8 pa1, bf16x8 pa2, bf16x8 pa3) {
#define TRRD(dst, off) asm volatile("ds_read_b64_tr_b16 %0, %1 offset:%2" : "=v"(dst) : "v"(vb0), "i"(off) : "memory")
#define PV_RD(S, d0) do { constexpr int b_ = VB * VBUF + v_rd_off(d0, 0, 0); \
        TRRD(S##l0, b_); TRRD(S##h0, b_ + 2048); TRRD(S##l1, b_ + 4096); TRRD(S##h1, b_ + 6144); TRRD(S##l2, b_ + 8192); TRRD(S##h2, b_ + 10240); TRRD(S##l3, b_ + 12288); TRRD(S##h3, b_ + 14336); } while (0)
#define PV_MM(S, d0, W) do { asm volatile("s_waitcnt lgkmcnt(%8)" : "+v"(S##l0), "+v"(S##h0), "+v"(S##l1), "+v"(S##h1), "+v"(S##l2), "+v"(S##h2), "+v"(S##l3), "+v"(S##h3) : "n"(W) : "memory"); \
        o[d0] = __builtin_amdgcn_mfma_f32_32x32x16_bf16(pa0, (bf16x8){S##l0[0], S##l0[1], S##l0[2], S##l0[3], S##h0[0], S##h0[1], S##h0[2], S##h0[3]}, o[d0], 0, 0, 0);   \
        o[d0] = __builtin_amdgcn_mfma_f32_32x32x16_bf16(pa1, (bf16x8){S##l1[0], S##l1[1], S##l1[2], S##l1[3], S##h1[0], S##h1[1], S##h1[2], S##h1[3]}, o[d0], 0, 0, 0);   \
        o[d0] = __builtin_amdgcn_mfma_f32_32x32x16_bf16(pa2, (bf16x8){S##l2[0], S##l2[1], S##l2[2], S##l2[3], S##h2[0], S##h2[1], S##h2[2], S##h2[3]}, o[d0], 0, 0, 0);   \
        o[d0] = __builtin_amdgcn_mfma_f32_32x32x16_bf16(pa3, (bf16x8){S##l3[0], S##l3[1], S##l3[2], S##l3[3], S##h3[0], S##h3[1], S##h3[2], S##h3[3]}, o[d0], 0, 0, 0); } while (0)
    s16x4 Al0, Al1, Al2, Al3, Ah0, Ah1, Ah2, Ah3, Bl0, Bl1, Bl2, Bl3, Bh0, Bh1, Bh2, Bh3;
    PV_RD(A, 0); PV_RD(B, 1);
    PV_MM(A, 0, 8); PV_RD(A, 2);
    PV_MM(B, 1, 8); PV_RD(B, 3);
    PV_MM(A, 2, 8);
    PV_MM(B, 3, 0);
#undef PV_MM
#undef PV_RD
#undef TRRD
}
__device__ __forceinline__ void attn_unit(int b, int h, int qb, const bf16_t* Q, const bf16_t* KN, const bf16_t* KR, const bf16_t* V, const bf16_t* G, bf16_t* O, char* lds) {
    int tid_ = threadIdx.x; asm volatile("" : "+v"(tid_));
    const int tid = tid_, wid = __builtin_amdgcn_readfirstlane(tid >> 6), lane = tid & 63, r32 = lane & 31, hi = lane >> 5;
    const size_t rowbase = (size_t)b * SEQ; const int q0 = qb * 256;
    char* V_lds = lds + OFF_V; char* K_lds = lds + OFF_K;
    float* wsf = (float*)(lds + OFF_WS) + wid * 64; float* li_l = wsf; float* al_l = wsf + 32;
    const int NT = (q0 + 256) / 64;
    const int qlo = q0 + wid * 32, qm = qlo + r32 - 4 * hi;
    const int sr = tid >> 4, sc = (tid & 15) * 8, vst0 = v_st(sr, sc), vst1 = v_st(32 + sr, sc), kws = sr * KP + sc * 2;
    const int rr = tid >> 3, rc = (tid & 7) * 8, krs = rr * KP + 256 + rc * 2;
    const int vb0 = (int)(uintptr_t)V_lds + v_rd_base(lane);
    const bf16_t* Kh = KN + rowbase * 1024 + h * 128 + sc; const bf16_t* Vh = V + rowbase * 1024 + h * 128 + sc; const bf16_t* Rh = KR + rowbase * 64 + rc;
    bf16x8 qr[12];
    { const bf16_t* qp = Q + (rowbase + qlo + r32) * 1536 + h * 192 + hi * 8;
#pragma unroll
      for (int d0 = 0; d0 < 12; ++d0) qr[d0] = *reinterpret_cast<const bf16x8*>(qp + d0 * 16); }
    bf16x8 sk0, sk1, skr, sv0, sv1;
#define LOADG(t) do { const size_t k0_ = (size_t)(t) * 64; sk0 = *(const bf16x8*)(Kh + (k0_ + sr) * 1024); sk1 = *(const bf16x8*)(Kh + (k0_ + 32 + sr) * 1024); \
        skr = *(const bf16x8*)(Rh + (k0_ + rr) * 64); sv0 = *(const bf16x8*)(Vh + (k0_ + sr) * 1024); sv1 = *(const bf16x8*)(Vh + (k0_ + 32 + sr) * 1024); } while (0)
#define WRITEL(bf) do { *(bf16x8*)(K_lds + (bf) * KBUF + kws) = sk0; *(bf16x8*)(K_lds + (bf) * KBUF + kws + 32 * KP) = sk1; *(bf16x8*)(K_lds + (bf) * KBUF + krs) = skr; \
        *(bf16x8*)(V_lds + (bf) * VBUF + vst0) = sv0; *(bf16x8*)(V_lds + (bf) * VBUF + vst1) = sv1; } while (0)
    float m_reg = -1e30f, l_reg = 0.f; f32x16 o[4] = {};
    f32x16 p0, p1; bf16x8 pa0, pa1, pa2, pa3; float alpha;
    LOADG(0); WRITEL(0); LOADG(1); __syncthreads();
#define STEP(BUF, t) do { \
        if ((t) + 1 < NT) WRITEL((BUF) ^ 1); \
        if ((t) + 2 < NT) LOADG((t) + 2); \
        SBAR(); __builtin_amdgcn_s_setprio(1); qkt<BUF>(p0, p1, K_lds, r32, hi, qr); __builtin_amdgcn_s_setprio(0); \
        { const int kb_ = (t) * 64; if (kb_ + 63 > qlo) mask_tile(p0, p1, qm - kb_); } \
        softmax_tile(p0, p1, m_reg, l_reg, alpha, pa0, pa1, pa2, pa3); \
        if (__any(alpha < 1.f)) { if (hi == 0) al_l[r32] = alpha; asm volatile("s_waitcnt lgkmcnt(0)" ::: "memory"); \
            _Pragma("unroll") for (int d_ = 0; d_ < 4; ++d_) _Pragma("unroll") for (int r = 0; r < 16; ++r) o[d_][r] *= al_l[crow(r, hi)]; } \
        SBAR(); __builtin_amdgcn_s_setprio(1); pv_tile<BUF>(o, vb0, pa0, pa1, pa2, pa3); __builtin_amdgcn_s_setprio(0); \
        __syncthreads(); } while (0)
    for (int t = 0; t < NT; t += 2) { STEP(0, t); STEP(1, t + 1); }
#undef STEP
#undef LOADG
#undef WRITEL
    if (hi == 0) li_l[r32] = l_reg; asm volatile("s_waitcnt lgkmcnt(0)" ::: "memory");
    const size_t obase = (rowbase + qlo) * 1024 + h * 128 + r32;
#pragma unroll
    for (int r = 0; r < 16; ++r) { const int orow = crow(r, hi); const float rli = __builtin_amdgcn_rcpf(li_l[orow]);
#pragma unroll
        for (int d0 = 0; d0 < 4; ++d0) { const size_t off = obase + (size_t)orow * 1024 + d0 * 32;
            const float gv = __uint_as_float(((unsigned)G[off]) << 16);
            const float v = o[d0][r] * rli * gv; const float vn = __shfl_xor(v, 1);
            if ((r32 & 1) == 0) *(unsigned*)(O + off) = cvtpk(v, vn); } }
    __syncthreads();
}
__device__ __forceinline__ void attn_phase(unsigned char* ws, char* lds, int vcu, int G_) {
    const bf16_t* Q = (const bf16_t*)(ws + WS_Q); const bf16_t* KN = (const bf16_t*)(ws + WS_KN); const bf16_t* KR = (const bf16_t*)(ws + WS_KROPE); const bf16_t* V = (const bf16_t*)(ws + WS_V); const bf16_t* G = (const bf16_t*)(ws + WS_GATE); bf16_t* O = (bf16_t*)(ws + WS_BUFA);
    for (int L = vcu; L < 1024; L += G_) { const int bh = L >> 4, x = L & 15;
        attn_unit(bh >> 3, bh & 7, 31 - x, Q, KN, KR, V, G, O, lds);
        attn_unit(bh >> 3, bh & 7, x, Q, KN, KR, V, G, O, lds); }
}
#undef SBAR
}

__device__ __forceinline__ float tanhf_(float x) { return 1.f - 2.f * __builtin_amdgcn_rcpf(__expf(2.f * x) + 1.f); }
__device__ __forceinline__ void lora_in_phase(const float* laraw, const float* mu  , bf16_t* la, int gt, int ngt) {
    for (int idx = gt; idx < T * 16; idx += ngt) {
        const int t = idx >> 4, g = idx & 15, c0 = g * 8; const int s = t & (SEQ - 1);
        const float* p = laraw + (size_t)t * 128 + c0;
        f32x4 r0 = *(const f32x4*)p, r1 = *(const f32x4*)(p + 4), q0 = {0.f, 0.f, 0.f, 0.f}, q1 = q0;
        if (s > 0) { q0 = *(const f32x4*)(p - 128); q1 = *(const f32x4*)(p - 124); }
        const f32x4 m0 = *(const f32x4*)(mu + 4096 + c0), m1 = *(const f32x4*)(mu + 4096 + c0 + 4);
        f32x4 v0 = r0 + m0 * (q0 - r0), v1 = r1 + m1 * (q1 - r1);
        if (g < 8) {
#pragma unroll
            for (int e = 0; e < 4; ++e) { v0[e] = tanhf_(v0[e]); v1[e] = tanhf_(v1[e]); } }
        *(u32x4*)(la + (size_t)t * 128 + c0) = pack8bf(v0, v1);
    }
}
namespace scan {
constexpr int STEP_F = 356, STEPB = STEP_F * 4, CH = 32, BUFB = CH * STEPB, OFF_Y = 2 * BUFB, YB = CH * 32 * 4, OFF_YD = OFF_Y + 2 * YB  , SCAN_LDS = OFF_YD + 512 * 4;
static_assert(SCAN_LDS <= 131072, "scan LDS");
template <int CTRL> __device__ __forceinline__ float dpp_add(float x) {
    return x + __builtin_bit_cast(float, __builtin_amdgcn_update_dpp(0, __builtin_bit_cast(int, x), CTRL, 0xf, 0xf, true));
}
__device__ __forceinline__ float allred16(float x) { x = dpp_add<0xB1>(x); x = dpp_add<0x4E>(x); x = dpp_add<0x141>(x); x = dpp_add<0x140>(x); return x; }

__device__ __forceinline__ void scan_item(int item, unsigned char* ws, const float* mu, const float* k_k, const float* k_a, const float* r_k, char* lds) {
    const bf16_t* PR = (const bf16_t*)(ws + WS_PR); const _Float16* E = (const _Float16*)(ws + WS_E); const _Float16* A = (const _Float16*)(ws + WS_A); bf16_t* Y = (bf16_t*)(ws + WS_BUFA); float* BON = (float*)(ws + WS_SSQ);
    int tid_ = threadIdx.x; asm volatile("" : "+v"(tid_));
    const int tid = tid_, wid = __builtin_amdgcn_readfirstlane(tid >> 6), lane = tid & 63;
    const int bh = item >> 1, half = item & 1, b = bh >> 4, h = bh & 15;
    const size_t rowbase = (size_t)b * SEQ;
    constexpr int NCH = SEQ / CH;
    typedef unsigned u32x2 __attribute__((ext_vector_type(2)));
    const int ls = tid >> 4, lq = tid & 15, c0 = h * 64 + lq * 4;
    const f32x4 mr = *(const f32x4*)(mu + c0), mk = *(const f32x4*)(mu + 1024 + c0), mv = *(const f32x4*)(mu + 2048 + c0), kkp = *(const f32x4*)(k_k + c0), kap = *(const f32x4*)(k_a + c0), rkp = *(const f32x4*)(r_k + c0);
    const bool myv = (lq >> 3) == half;
    u32x2 g_rt, g_kt, g_vt, g_rp, g_kp, g_vp, g_et, g_at;
#define SC_LOAD(cn) do { const int sg_ = (cn) * CH + ls; const bf16_t* pr_ = PR + (rowbase + sg_) * 4096 + c0; \
        g_rt = *(const u32x2*)pr_; g_kt = *(const u32x2*)(pr_ + 1024); g_vt = *(const u32x2*)(pr_ + 2048); \
        const bf16_t* pp_ = sg_ > 0 ? pr_ - 4096 : pr_; g_rp = *(const u32x2*)pp_; g_kp = *(const u32x2*)(pp_ + 1024); g_vp = *(const u32x2*)(pp_ + 2048); \
        g_et = *(const u32x2*)(E + (rowbase + sg_) * 1024 + c0); g_at = *(const u32x2*)(A + (rowbase + sg_) * 1024 + c0); } while (0)
#define SC_CVT(cn) do { const float pm_ = ((cn) * CH + ls) > 0 ? 1.f : 0.f; \
        f32x4 r_ = {bf_lo(g_rt.x), bf_hi(g_rt.x), bf_lo(g_rt.y), bf_hi(g_rt.y)}, k_ = {bf_lo(g_kt.x), bf_hi(g_kt.x), bf_lo(g_kt.y), bf_hi(g_kt.y)}, v_ = {bf_lo(g_vt.x), bf_hi(g_vt.x), bf_lo(g_vt.y), bf_hi(g_vt.y)}; \
        const f32x4 rq_ = (f32x4){bf_lo(g_rp.x), bf_hi(g_rp.x), bf_lo(g_rp.y), bf_hi(g_rp.y)} * pm_, kq_ = (f32x4){bf_lo(g_kp.x), bf_hi(g_kp.x), bf_lo(g_kp.y), bf_hi(g_kp.y)} * pm_, vq_ = (f32x4){bf_lo(g_vp.x), bf_hi(g_vp.x), bf_lo(g_vp.y), bf_hi(g_vp.y)} * pm_; \
        const f32x4 e_ = {h_lo(g_et.x), h_hi(g_et.x), h_lo(g_et.y), h_hi(g_et.y)}, a_ = {h_lo(g_at.x), h_hi(g_at.x), h_lo(g_at.y), h_hi(g_at.y)}; \
        r_ += mr * (rq_ - r_); k_ += mk * (kq_ - k_); v_ += mv * (vq_ - v_); \
        const f32x4 kkv_ = k_ * kkp; float ss_ = (kkv_[0] * kkv_[0] + kkv_[1] * kkv_[1]) + (kkv_[2] * kkv_[2] + kkv_[3] * kkv_[3]); ss_ = allred16(ss_); \
        const float inv_ = __builtin_amdgcn_rsqf(fmaxf(ss_, 1e-24f)); const f32x4 kk_ = kkv_ * inv_;     \
        float* st_ = (float*)(lds + ((cn) & 1) * BUFB + ls * STEPB) + lq * 4; \
        *(f32x4*)(st_) = -kk_; \
        *(f32x4*)(st_ + 64) = (f32x4){__expf(-e_[0]), __expf(-e_[1]), __expf(-e_[2]), __expf(-e_[3])}; \
        *(f32x4*)(st_ + 128) = kk_ * a_; \
        const f32x4 kf_ = k_ * ((a_ - 1.f) * kap + 1.f); *(f32x4*)(st_ + 192) = kf_; \
        if (half == 0) { const f32x4 bq_ = r_ * kf_ * rkp; float bn_ = allred16((bq_[0] + bq_[1]) + (bq_[2] + bq_[3])); if (lq == 0) BON[(rowbase + (size_t)(cn) * CH + ls) * 16 + h] = bn_; } \
        *(f32x4*)(st_ + 256) = r_; \
        if (myv) *(f32x4*)((float*)(lds + ((cn) & 1) * BUFB + ls * STEPB) + 320 + (lq & 7) * 4) = v_; } while (0)
#define SC_YOUT(cn) do { if (lq < 8) { const f32x4 y_ = *(const f32x4*)((const float*)(lds + OFF_Y + ((cn) & 1) * YB) + ls * 32 + lq * 4); \
        u32x2 o_; o_.x = cvtpk(y_[0], y_[1]); o_.y = cvtpk(y_[2], y_[3]); \
        *(u32x2*)(Y + (rowbase + (size_t)(cn) * CH + ls) * 1024 + h * 64 + half * 32 + lq * 4) = o_; } } while (0)
    const int cgp = lane & 15, row = wid * 4 + (lane >> 4);
    f32x4 S = {0.f, 0.f, 0.f, 0.f};
    SC_LOAD(0); SC_CVT(0);
    __syncthreads();
    for (int c = 0; c < NCH; ++c) {
        if (c > 0) SC_YOUT(c - 1);
        if (c + 1 < NCH) SC_LOAD(c + 1);
        const float* base = (const float*)(lds + (c & 1) * BUFB) + cgp * 4;
        const float* vbp = (const float*)(lds + (c & 1) * BUFB) + 320 + row;
        float* yb = (float*)(lds + OFF_Y + (c & 1) * YB) + row;
        float* ybw = cgp == 0 ? yb : (float*)(lds + OFF_YD) + wid * 64 + lane; const int ybs = cgp == 0 ? 32 : 0;
        f32x4 a4 = *(const f32x4*)(base), w4 = *(const f32x4*)(base + 64), b4 = *(const f32x4*)(base + 128), k4 = *(const f32x4*)(base + 192), r4 = *(const f32x4*)(base + 256);
        float v1 = *vbp; float ypart = 0.f;
#pragma unroll 4
        for (int s = 0; s < CH; ++s) {
            const int sn = s + 1;
            const float* st = base + sn * STEP_F;
            const f32x4 na4 = *(const f32x4*)(st), nw4 = *(const f32x4*)(st + 64), nb4 = *(const f32x4*)(st + 128), nk4 = *(const f32x4*)(st + 192), nr4 = *(const f32x4*)(st + 256);
            const float nv1 = vbp[sn * STEP_F];
            float p = (S[0] * a4[0] + S[1] * a4[1]) + (S[2] * a4[2] + S[3] * a4[3]);
            p = dpp_add<0xB1>(p); ypart = dpp_add<0xB1>(ypart); p = dpp_add<0x4E>(p); ypart = dpp_add<0x4E>(ypart);
            p = dpp_add<0x141>(p); ypart = dpp_add<0x141>(ypart); p = dpp_add<0x140>(p); ypart = dpp_add<0x140>(ypart);
            if (s > 0) ybw[(s - 1) * ybs] = ypart;
            S = S * w4 + (b4 * p + k4 * v1);
            ypart = (S[0] * r4[0] + S[1] * r4[1]) + (S[2] * r4[2] + S[3] * r4[3]);
            a4 = na4; w4 = nw4; b4 = nb4; k4 = nk4; r4 = nr4; v1 = nv1;
        }
        ypart = allred16(ypart);
        ybw[(CH - 1) * ybs] = ypart;
        if (c + 1 < NCH) SC_CVT(c + 1);
        __syncthreads();
    }
    SC_YOUT(NCH - 1);
    __syncthreads();
#undef SC_LOAD
#undef SC_CVT
#undef SC_YOUT
}
}

__device__ __forceinline__ void post_phase(unsigned char* ws, const float* mu, const float* ln_g, const float* ln_b, int gt, int ngt) {
    const bf16_t* PR = (const bf16_t*)(ws + WS_PR); bf16_t* Y = (bf16_t*)(ws + WS_BUFA); const float* BON = (const float*)(ws + WS_SSQ);
    for (int idx = gt; idx < T * 128; idx += ngt) {
        const int t = idx >> 7, g = idx & 127, c0 = g * 8; const int s = t & (SEQ - 1);
        const bf16_t* pr = PR + (size_t)t * 4096 + c0;
        u32x4 vt = *(const u32x4*)(pr + 2048), gt_ = *(const u32x4*)(pr + 3072);
        u32x4 vp = {0u, 0u, 0u, 0u}, gp = vp;
        if (s > 0) { vp = *(const u32x4*)(pr - 4096 + 2048); gp = *(const u32x4*)(pr - 4096 + 3072); }
        const u32x4 yt = *(const u32x4*)(Y + (size_t)t * 1024 + c0);
        const float bon = BON[(size_t)t * 16 + (g >> 3)];
        float v_[8], g_[8], vq[8], gq[8], y_[8];
        unpack8bf(vt, v_); unpack8bf(gt_, g_); unpack8bf(vp, vq); unpack8bf(gp, gq); unpack8bf(yt, y_);
        float ysum = 0.f;
#pragma unroll
        for (int e = 0; e < 8; ++e) { const int c = c0 + e;
            v_[e] += mu[2048 + c] * (vq[e] - v_[e]); g_[e] += mu[3072 + c] * (gq[e] - g_[e]); ysum += y_[e]; }
        ysum += __shfl_xor(ysum, 1); ysum += __shfl_xor(ysum, 2); ysum += __shfl_xor(ysum, 4);
        const float mean = ysum * (1.f / 64.f); float var = 0.f;
#pragma unroll
        for (int e = 0; e < 8; ++e) { const float d = y_[e] - mean; var += d * d; }
        var += __shfl_xor(var, 1); var += __shfl_xor(var, 2); var += __shfl_xor(var, 4);
        const float rstd = 1.0f / sqrtf(var * (1.f / 64.f) + GN_EPS);
        f32x4 o0, o1;
#pragma unroll
        for (int e = 0; e < 8; ++e) { const int c = c0 + e;
            const float yn = (y_[e] - mean) * rstd * ln_g[c] + ln_b[c] + bon * v_[e];
            const float ov = yn * siluf_(g_[e]);
            if (e < 4) o0[e] = ov; else o1[e - 4] = ov; }
        *(u32x4*)(Y + (size_t)t * 1024 + c0) = pack8bf(o0, o1);
    }
}

#define LAS __attribute__((address_space(3)))
#define XB_TMO      128
#define XB_XCNT(j)  (256  + 64 * (j))
#define XB_XSUB(j)  (1280 + 64 * (j))
#define XB_XGEN(j)  (2304 + 64 * (j))
#define XB_TOP      3328
#define XB_TOPGEN   3392
#define XCD_BAR_WORDS 3456
#define XB_SPIN_CAP (1u << 18)

__device__ __forceinline__ unsigned xb_ld(unsigned* p)              { return __hip_atomic_load(p, __ATOMIC_RELAXED, __HIP_MEMORY_SCOPE_AGENT); }
__device__ __forceinline__ unsigned xb_add(unsigned* p, unsigned v) { return __hip_atomic_fetch_add(p, v, __ATOMIC_RELAXED, __HIP_MEMORY_SCOPE_AGENT); }
__device__ __forceinline__ unsigned xb_xcc_id() { return (unsigned)__builtin_amdgcn_s_getreg((3 << 11) | 20) & 0xFu; }
#define XB_SPIN(cond, bar) do { unsigned _sp = 0; while (cond) { __builtin_amdgcn_s_sleep(1); \
    if ((++_sp & 255u) == 0u) { if (xb_ld(&(bar)[XB_TMO])) break; if (_sp > XB_SPIN_CAP) { atomicAdd(&(bar)[XB_TMO], 1u); break; } } } } while (0)

struct XcdBarrier {
    unsigned* bar; unsigned x;
    volatile LAS unsigned* st;
};

__device__ __forceinline__ XcdBarrier xcd_barrier_post(unsigned* bar, volatile LAS unsigned* st) {
    XcdBarrier b; b.bar = bar; b.x = xb_xcc_id(); b.st = st;
    if (threadIdx.x == 0) (void)xb_add(&bar[XB_XCNT(b.x)], 1u);
    return b;
}
__device__ __forceinline__ void xcd_barrier_complete(unsigned* bar, unsigned x, unsigned& nloc, unsigned& nx) {
    const unsigned G = gridDim.x * gridDim.y * gridDim.z;
    unsigned sum, cnt, mine, sp = 0u;
    for (;;) {
        sum = 0u; cnt = 0u; mine = 0u;
#pragma unroll
        for (unsigned j = 0; j < 16; ++j) { const unsigned c = xb_ld(&bar[XB_XCNT(j)]); sum += c; cnt += (c > 0u) ? 1u : 0u; mine = (j == x) ? c : mine; }
        if (sum == G) break;
        __builtin_amdgcn_s_sleep(1);
        if ((++sp & 255u) == 0u) { if (xb_ld(&bar[XB_TMO])) break; if (sp > XB_SPIN_CAP) { atomicAdd(&bar[XB_TMO], 1u); break; } }
    }
    nloc = mine > 0u ? mine : 1u; nx = cnt > 0u ? cnt : 1u;
}

__device__ __forceinline__ void xcd_barrier(const XcdBarrier& b) {
    asm volatile("s_waitcnt vmcnt(0)" ::: "memory");
    __syncthreads();
    if (threadIdx.x == 0) {
        unsigned* bar = b.bar;
        __builtin_amdgcn_s_waitcnt(0);
        unsigned nloc = b.st[0], nx = b.st[1];
        if (nloc == 0u) { xcd_barrier_complete(bar, b.x, nloc, nx); b.st[0] = nloc; b.st[1] = nx; }
        const unsigned old = xb_add(&bar[XB_XSUB(b.x)], 1u);
        const unsigned gen = old / nloc;
        if (old + 1u == (gen + 1u) * nloc) {
            __builtin_amdgcn_fence(__ATOMIC_RELEASE, "agent");
            asm volatile("s_waitcnt vmcnt(0)" ::: "memory");
            const unsigned og = xb_add(&bar[XB_TOP], 1u);
            const unsigned tg = og / nx;
            if (og + 1u == (tg + 1u) * nx) xb_add(&bar[XB_TOPGEN], 1u);
            else XB_SPIN(xb_ld(&bar[XB_TOPGEN]) == tg, bar);
            __builtin_amdgcn_fence(__ATOMIC_ACQUIRE, "agent");
            xb_add(&bar[XB_XGEN(b.x)], 1u);
            asm volatile("s_waitcnt vmcnt(0)" ::: "memory");
        } else {
            XB_SPIN(xb_ld(&bar[XB_XGEN(b.x)]) == gen, bar);
            __builtin_amdgcn_fence(__ATOMIC_ACQUIRE, "agent");
            asm volatile("s_waitcnt vmcnt(0)" ::: "memory");
        }
    }
    __syncthreads();
}

__global__ void __launch_bounds__(NTHREADS, 2) fwd_megakernel(Args a) {
    extern __shared__ __attribute__((aligned(16))) unsigned char lds[];
    cg::grid_group grid = cg::this_grid();
    const int ph_hi = a.ph_hi < 22 ? a.ph_hi : 22;
    if (threadIdx.x < 64) ((LAS unsigned*)(lds + LDS_MISC))[threadIdx.x] = 0u;
    __syncthreads();
    { typedef const __attribute__((address_space(4))) Args* ArgsP0; ArgsP0 ap0 = (ArgsP0)__builtin_amdgcn_kernarg_segment_ptr();
      (void)xcd_barrier_post((unsigned*)(ap0->ws + WS_BAR), (volatile LAS unsigned*)(lds + LDS_MISC)); }
#pragma nounroll
    for (int p = a.ph_lo; p < ph_hi; ++p) {
        typedef const __attribute__((address_space(4))) Args* ArgsP;
        ArgsP ap = (ArgsP)__builtin_amdgcn_kernarg_segment_ptr(); asm volatile("" : "+s"(ap));
        int pp = p; asm volatile("" : "+s"(pp));
        int G0_ = gridDim.x, bx0_ = blockIdx.x; asm volatile("" : "+s"(G0_), "+s"(bx0_));
        const int G_ = G0_, bx = bx0_;
        const int vcu = (G_ % 8 == 0) ? (bx % 8) * (G_ / 8) + bx / 8 : bx;
#define TIDS() int tid_ = threadIdx.x; asm volatile("" : "+v"(tid_)); const int lane = tid_ & 63, wave = __builtin_amdgcn_readfirstlane(tid_ >> 6); \
        const int gw = vcu * 8 + wave, ngw = G_ * 8, gt = gw * 64 + lane, ngt = ngw * 64; (void)gt; (void)ngt; (void)gw; (void)ngw
        unsigned char* ws = ap->ws;
        PG8_LAS unsigned char* lds3 = (PG8_LAS unsigned char*)lds;
        const int q_ = pp - 1, jj = q_ / 10, r = q_ - jj * 10;
        const int rr_ = pp == 0 ? 10 : (pp == 21 ? 11 : r);
        bf16_t* XB = (bf16_t*)ap->out;
        switch (rr_) {
        case 11: { TIDS(); final_norm((const float*)(ws + WS_XF), ap->out, (const float*)ap->in[21], gw, ngw, lane); } break;
        case 10: { TIDS();
            prep_weights(ap, lds, wave, lane, gw, ngw);
            conv_rows_bf16((const float*)ap->in[0], XB, (float*)(ws + WS_SSX), gw, ngw, lane);
        } break;
        case 0: {
            int K_ = 1024; asm volatile("" : "+s"(K_)); pg8::Gemm g{XB, (const bf16_t*)(ws + WS_W + (size_t)jj * SZ_MLA), T, 2304, K_}; pg8::StaticOrder S; S.init(T, 2304, G_, bx);
            pg8::EpiMlaIn E{ws, (const int*)ap->in[1]};
            pg8::gemm_phase<pg8::EpiMlaIn, pg8::StaticOrder, true, true>(lds3, g, S, E);
        } break;
        case 1: {
            { int K_ = 768; asm volatile("" : "+s"(K_)); pg8::Gemm g{(const bf16_t*)(ws + WS_QLAT), (const bf16_t*)(ws + WS_W + (size_t)jj * SZ_MLA + SZ_MWIN), T, 1536, K_}; pg8::StaticOrder S; S.init(T, 1536, G_, bx);
              pg8::EpiUq E{ws, (const int*)ap->in[1]};
              pg8::gemm_phase<pg8::EpiUq, pg8::StaticOrder, true, true>(lds3, g, S, E); }
            { int K_ = 256; asm volatile("" : "+s"(K_)); pg8::Gemm g{(const bf16_t*)(ws + WS_KVLAT), (const bf16_t*)(ws + WS_W + (size_t)jj * SZ_MLA + SZ_MWIN + SZ_MWUQ), T, 2048, K_}; pg8::StaticOrder S; S.init(T, 2048, G_, bx);
              pg8::EpiUkv E{ws};
              pg8::gemm_phase<pg8::EpiUkv, pg8::StaticOrder, true, true>(lds3, g, S, E); }
        } break;
        case 2: { att::attn_phase(ws, (char*)lds, vcu, G_); } break;
        case 3: case 9: {
            const size_t woff = r == 3 ? WS_W + (size_t)jj * SZ_MLA + SZ_MWIN + SZ_MWUQ + SZ_MWUKV : WS_W + 2 * SZ_MLA + (size_t)jj * SZ_RWKV + SZ_RWIN + SZ_RWL;
            int K_ = 1024; asm volatile("" : "+s"(K_)); pg8::Gemm g{(const bf16_t*)(ws + WS_BUFA), (const bf16_t*)(ws + woff), T, 1024, K_}; pg8::StaticOrder S; S.init(T, 1024, G_, bx);
            pg8::EpiResid E{XB, (float*)(ws + WS_SSX), pp == 20 ? (float*)(ws + WS_XF) : (float*)nullptr};
            pg8::gemm_phase<pg8::EpiResid, pg8::StaticOrder, true, true>(lds3, g, S, E);
        } break;
        case 4: {
            int K_ = 1024; asm volatile("" : "+s"(K_)); pg8::Gemm g{XB, (const bf16_t*)(ws + WS_W + 2 * SZ_MLA + (size_t)jj * SZ_RWKV), T, 4352, K_}; pg8::StaticOrder S; S.init(T, 4352, G_, bx);
            pg8::EpiRwkvIn E{ws};
            pg8::gemm_phase<pg8::EpiRwkvIn, pg8::StaticOrder, true, true>(lds3, g, S, E);
        } break;
        case 5: { TIDS(); lora_in_phase((const float*)(ws + WS_LARAW), (const float*)ap->in[10] + jj * 4224, (bf16_t*)(ws + WS_LA), gt, ngt); } break;
        case 6: {
            int K_ = 128; asm volatile("" : "+s"(K_)); pg8::Gemm g{(const bf16_t*)(ws + WS_LA), (const bf16_t*)(ws + WS_W + 2 * SZ_MLA + (size_t)jj * SZ_RWKV + SZ_RWIN), T, 2048, K_}; pg8::StaticOrder S; S.init(T, 2048, G_, bx);
            pg8::EpiLora E{ws, (const float*)ap->in[11] + jj * 1024, (const float*)ap->in[13] + jj * 1024};
            pg8::gemm_phase<pg8::EpiLora, pg8::StaticOrder, true, true>(lds3, g, S, E);
        } break;
        case 7: {
            for (int item = vcu; item < 256; item += G_)
                scan::scan_item(item, ws, (const float*)ap->in[10] + jj * 4224, (const float*)ap->in[15] + jj * 1024, (const float*)ap->in[16] + jj * 1024, (const float*)ap->in[17] + jj * 1024, (char*)lds);
        } break;
        default: { TIDS();
            post_phase(ws, (const float*)ap->in[10] + jj * 4224, (const float*)ap->in[18] + jj * 1024, (const float*)ap->in[19] + jj * 1024, gt, ngt);
        } break;
        }
        if (p + 1 < ph_hi) {
            if (p == a.ph_lo) grid.sync();
            else { XcdBarrier xb; xb.bar = (unsigned*)(ws + WS_BAR); xb.x = xb_xcc_id(); xb.st = (volatile LAS unsigned*)(lds + LDS_MISC); xcd_barrier(xb); }
        }
    }
}

extern "C" void kernel_launch(void* const* d_in, const int* in_sizes, int n_in, void* d_out, int out_size, void* d_ws, size_t ws_size, hipStream_t stream) {
    static int grid = 0;
    if (grid == 0) {
        if (n_in != 22 || in_sizes[0] != T * DM || out_size != T * DM || ws_size < WS_END) {
            fprintf(stderr, "kernel_launch: unexpected shapes (n_in %d, in0 %d, out %d, ws %zu, need %zu); nothing launched\n", n_in, n_in > 0 ? in_sizes[0] : -1, out_size, ws_size, (size_t)WS_END);
            grid = -1; return; }
        int dev = 0, cus = 0, per_cu = 0;
        (void)hipGetDevice(&dev);
        (void)hipDeviceGetAttribute(&cus, hipDeviceAttributeMultiprocessorCount, dev);
        if (hipFuncSetAttribute((const void*)fwd_megakernel, hipFuncAttributeMaxDynamicSharedMemorySize, LDS_BYTES) != hipSuccess) fprintf(stderr, "kernel_launch: hipFuncSetAttribute failed\n");
        if (hipOccupancyMaxActiveBlocksPerMultiprocessor(&per_cu, (const void*)fwd_megakernel, NTHREADS, LDS_BYTES) != hipSuccess || per_cu < 1) { fprintf(stderr, "kernel_launch: occupancy query gave %d\n", per_cu); per_cu = 1; }
        (void)hipGetLastError();
        if (cus <= 0) cus = 256;
        grid = cus * per_cu;
        fprintf(stderr, "kernel_launch: grid %d (cus %d x %d)\n", grid, cus, per_cu);
    }
    if (grid < 0) return;
    if (hipMemsetAsync((char*)d_ws + WS_BAR, 0, BAR_BYTES, stream) != hipSuccess) { fprintf(stderr, "kernel_launch: memset failed\n"); return; }
    Args a{};
    for (int i = 0; i < 22; ++i) a.in[i] = d_in[i];
    a.out = (float*)d_out; a.ws = (unsigned char*)d_ws;
#if defined(MK_MULTI)
    for (int p = 0; p < 22; ++p) { a.ph_lo = p; a.ph_hi = p + 1; hipLaunchKernelGGL(fwd_megakernel, dim3(grid), dim3(NTHREADS), LDS_BYTES, stream, a); }
#else
    a.ph_lo = 0; a.ph_hi = 1000;
    void* args[] = {&a};
    hipError_t e = hipLaunchCooperativeKernel((const void*)fwd_megakernel, dim3(grid), dim3(NTHREADS), args, LDS_BYTES, stream);
    if (e != hipSuccess) fprintf(stderr, "kernel_launch: cooperative launch failed: %s (grid %d)\n", hipGetErrorString(e), grid);
#endif
}
```

```cpp
#include <hip/hip_runtime.h>
#include <hip/hip_cooperative_groups.h>
#include <cstdio>
#include <cstdint>
#include <cmath>
namespace cg = cooperative_groups;
namespace pg8 {
#define PG8_LAS __attribute__((address_space(3)))
typedef unsigned short bf16_t;
typedef short bf16x8 __attribute__((ext_vector_type(8)));
typedef float f32x4 __attribute__((ext_vector_type(4)));
typedef unsigned u32x4 __attribute__((ext_vector_type(4)));
constexpr int BM = 256, BK = 64, HALF = 128, HTB = HALF * BK * 2  , STAGE_BYTES = 8 * HTB, NXCD = 8, WGM = 8;

__host__ __device__ __forceinline__ int lds_byte(int r, int c) { const int st = (r >> 4) * 2 + (c >> 5), rr = r & 15, cc = c & 31, ob = rr * 64 + cc * 2; return st * 1024 + (ob ^ (((ob >> 9) & 1) << 5)); }
__host__ __device__ __forceinline__ void stage_rc(int b, int& R, int& C) { const int st = b / 1024, sb = b % 1024, swz = sb ^ (((sb >> 9) & 1) << 5); R = (st >> 1) * 16 + swz / 64; C = (st & 1) * 32 + (swz % 64) / 2; }
__host__ __device__ __forceinline__ int perm32(int rho) { const int n = rho >> 4, i = rho & 15; return 8 * (i >> 2) + 4 * n + (i & 3); }

struct Unit { int pm, pn; };
struct Gemm { const bf16_t* A; const bf16_t* Bt; int M, N, K; };

struct StaticOrder {
    int nM, nN, nwg, G, c;
    __host__ __device__ void init(int M, int N, int G_, int c_) { nM = M / BM; nN = N / BM; nwg = nM * nN; G = G_; c = c_; }
    __host__ __device__ bool next(int i, Unit& u) const {
        const long L = (long)i * G + c; if (L >= nwg) return false;
        int wgid = (int)L; { const int q = nwg / NXCD, r = nwg % NXCD, xcd = wgid % NXCD, off = wgid / NXCD; wgid = (xcd < r ? xcd * (q + 1) : r * (q + 1) + (xcd - r) * q) + off; }
        const int nig = WGM * nN, gid = wgid / nig, fm = gid * WGM, gsz = (nM - fm) < WGM ? (nM - fm) : WGM;
        u.pm = fm + ((wgid % nig) % gsz); u.pn = (wgid % nig) / gsz; return true;
    }
    __device__ __forceinline__ void a_ready(const Unit&) const {}
    __device__ __forceinline__ void done(const Unit&) const {}
};

__device__ __forceinline__ unsigned cvt_pk_bf16(float lo, float hi) { unsigned r; asm volatile("v_cvt_pk_bf16_f32 %0, %1, %2" : "=v"(r) : "v"(lo), "v"(hi)); return r; }
typedef float f32x2 __attribute__((ext_vector_type(2)));
template <class Epi, class Sched, bool ALIGN_EPI = false, bool SP2 = false>
__device__ __forceinline__ void gemm_phase(PG8_LAS unsigned char* lds, const Gemm g, const Sched& S, const Epi& E) {
    int tid_ = threadIdx.x; asm volatile("" : "+v"(tid_));
    const int tid = tid_, wid = __builtin_amdgcn_readfirstlane(tid >> 6), lane = tid & 63, wr = wid >> 2, wc = wid & 3, fr = lane & 15, fq = lane >> 4;
    const int K = g.K, nt = K / BK;
    unsigned voffA[2], voffB[2];
#pragma unroll
    for (int i = 0; i < 2; ++i) { int R, C; stage_rc(tid * 16 + i * 8192, R, C); const int Rb = Epi::PERM ? ((R & ~31) + perm32(R & 31)) : R;
        voffA[i] = (unsigned)(R * K + C) * 2u; voffB[i] = (unsigned)(Rb * K + C) * 2u; }
    const size_t kstep = (size_t)(BK * 2);
    const size_t hstep = (size_t)HALF * K * 2;
    const size_t tstep = 2 * hstep;
    const unsigned ldsw = (unsigned)wid * 1024u;
    const int aoff = lds_byte(wr * 64 + fr, fq * 8), boff = lds_byte(wc * 32 + fr, fq * 8);
#define PG8_SA(b, h) (((b) * 2 + (h)) * HTB)
#define PG8_SB(b, h) ((4 + (b) * 2 + (h)) * HTB)
#define PG8_STAGE(bufoff, gbase, voff) do { _Pragma("unroll") for (int _i = 0; _i < 2; ++_i) \
        __builtin_amdgcn_global_load_lds((const unsigned*)((const char*)(gbase) + (voff)[_i]), (PG8_LAS unsigned*)(lds + (bufoff) + ldsw + _i * 8192), 16, 0, 0); } while (0)
#define PG8_LDA(dst, b, h) do { _Pragma("unroll") for (int m = 0; m < 4; ++m) _Pragma("unroll") for (int k = 0; k < 2; ++k) dst[m][k] = *(const PG8_LAS bf16x8*)(lds + PG8_SA(b, h) + aoff + m * 2048 + k * 1024); } while (0)
#define PG8_LDB(dst, b, h) do { _Pragma("unroll") for (int n = 0; n < 2; ++n) _Pragma("unroll") for (int k = 0; k < 2; ++k) dst[n][k] = *(const PG8_LAS bf16x8*)(lds + PG8_SB(b, h) + boff + n * 2048 + k * 1024); } while (0)
#define PG8_MMA(ai, bj, At, Bt) do { __builtin_amdgcn_s_setprio(1); _Pragma("unroll") for (int m = 0; m < 4; ++m) _Pragma("unroll") for (int n = 0; n < 2; ++n) _Pragma("unroll") for (int k = 0; k < 2; ++k) \
        acc[ai][bj][m][n] = __builtin_amdgcn_mfma_f32_16x16x32_bf16(Bt[n][k], At[m][k], acc[ai][bj][m][n], 0, 0, 0); __builtin_amdgcn_s_setprio(0); } while (0)
#define PG8_WAIT_V(n) asm volatile("s_waitcnt vmcnt(" #n ")" ::: "memory")
#define PG8_WAIT_L(n) asm volatile("s_waitcnt lgkmcnt(" #n ")" ::: "memory")
#define PG8_BAR __builtin_amdgcn_s_barrier()
#define PG8_SCHED __builtin_amdgcn_sched_barrier(0)
    Unit cur, nxt; int ui = 0;
    if (!S.next(0, cur)) return;
    f32x4 acc[2][2][4][2];
#pragma unroll
    for (int a = 0; a < 2; ++a)
#pragma unroll
        for (int b = 0; b < 2; ++b)
#pragma unroll
            for (int m = 0; m < 4; ++m)
#pragma unroll
                for (int n = 0; n < 2; ++n) acc[a][b][m][n] = (f32x4){0.f, 0.f, 0.f, 0.f};
    bf16x8 At[4][2], B0[2][2], B1[2][2];
    const char* cA = (const char*)g.A + (size_t)cur.pm * tstep; const char* cB = (const char*)g.Bt + (size_t)cur.pn * tstep;
    S.a_ready(cur);
    if constexpr (SP2) {
        PG8_STAGE(PG8_SB(0, 0), cB, voffB); PG8_STAGE(PG8_SB(0, 1), cB + hstep, voffB); PG8_STAGE(PG8_SA(0, 0), cA, voffA); PG8_STAGE(PG8_SA(0, 1), cA + hstep, voffA);
        if (wr == 1) PG8_BAR;
        PG8_WAIT_V(2); PG8_BAR;
        PG8_STAGE(PG8_SB(1, 0), cB + kstep, voffB); PG8_STAGE(PG8_SA(1, 0), cA + kstep, voffA); PG8_STAGE(PG8_SB(1, 1), cB + hstep + kstep, voffB);
        PG8_WAIT_V(6); PG8_BAR;
    } else {
        PG8_STAGE(PG8_SB(0, 0), cB, voffB); PG8_STAGE(PG8_SA(0, 0), cA, voffA); PG8_STAGE(PG8_SB(0, 1), cB + hstep, voffB); PG8_STAGE(PG8_SA(0, 1), cA + hstep, voffA);
        if (wr == 1) PG8_BAR;
        PG8_WAIT_V(4); PG8_BAR;
        PG8_STAGE(PG8_SB(1, 0), cB + kstep, voffB); PG8_STAGE(PG8_SA(1, 0), cA + kstep, voffA); PG8_STAGE(PG8_SB(1, 1), cB + hstep + kstep, voffB);
        PG8_WAIT_V(6); PG8_BAR;
    }
    for (;;) {
        const bool has_next = S.next(ui + 1, nxt);
        const char* nA = has_next ? (const char*)g.A + (size_t)nxt.pm * tstep : cA; const char* nB = has_next ? (const char*)g.Bt + (size_t)nxt.pn * tstep : cB;
        for (int t = 0; t < nt; t += 2) {
            const bool last = (t == nt - 2);
            const char* a1 = cA + (size_t)(t + 1) * kstep;
            const char* a2 = last ? nA : cA + (size_t)(t + 2) * kstep; const char* b2 = last ? nB : cB + (size_t)(t + 2) * kstep;
            const char* a3 = a2 + kstep; const char* b3 = b2 + kstep;
            if (last && has_next) S.a_ready(nxt);
            if constexpr (SP2) {
            PG8_LDB(B0, 0, 0); PG8_LDB(B1, 0, 1); PG8_SCHED; PG8_LDA(At, 0, 0); PG8_STAGE(PG8_SA(1, 1), a1 + hstep, voffA);
            PG8_WAIT_V(8); PG8_WAIT_L(0); PG8_BAR; PG8_MMA(0, 0, At, B0); PG8_MMA(0, 1, At, B1); PG8_BAR; PG8_SCHED;
            PG8_LDA(At, 0, 1); PG8_STAGE(PG8_SB(0, 0), b2, voffB); PG8_STAGE(PG8_SB(0, 1), b2 + hstep, voffB); PG8_STAGE(PG8_SA(0, 0), a2, voffA);
            PG8_WAIT_V(8); PG8_WAIT_L(0); PG8_BAR; PG8_MMA(1, 0, At, B0); PG8_MMA(1, 1, At, B1); PG8_BAR; PG8_SCHED;
            PG8_LDB(B0, 1, 0); PG8_LDB(B1, 1, 1); PG8_SCHED; PG8_LDA(At, 1, 0); PG8_STAGE(PG8_SA(0, 1), a2 + hstep, voffA);
            PG8_WAIT_V(8); PG8_WAIT_L(0); PG8_BAR; PG8_MMA(0, 0, At, B0); PG8_MMA(0, 1, At, B1); PG8_BAR; PG8_SCHED;
            PG8_LDA(At, 1, 1); PG8_STAGE(PG8_SB(1, 0), b3, voffB); PG8_STAGE(PG8_SB(1, 1), b3 + hstep, voffB); PG8_STAGE(PG8_SA(1, 0), a3, voffA);
            PG8_WAIT_V(8); PG8_WAIT_L(0); PG8_BAR; PG8_MMA(1, 0, At, B0); PG8_MMA(1, 1, At, B1); PG8_BAR; PG8_SCHED;
            } else {
            PG8_LDB(B0, 0, 0); PG8_SCHED; PG8_LDA(At, 0, 0); PG8_STAGE(PG8_SA(1, 1), a1 + hstep, voffA);
            PG8_WAIT_L(8); PG8_BAR; PG8_WAIT_L(0); PG8_MMA(0, 0, At, B0); PG8_BAR; PG8_SCHED;
            PG8_LDB(B1, 0, 1); PG8_STAGE(PG8_SB(0, 0), b2, voffB);
            PG8_BAR; PG8_WAIT_L(0); PG8_MMA(0, 1, At, B1); PG8_BAR;
            PG8_LDA(At, 0, 1); PG8_STAGE(PG8_SA(0, 0), a2, voffA);
            PG8_BAR; PG8_WAIT_L(0); PG8_MMA(1, 0, At, B0); PG8_BAR; PG8_SCHED;
            PG8_STAGE(PG8_SB(0, 1), b2 + hstep, voffB);
            PG8_WAIT_V(6); PG8_BAR; PG8_MMA(1, 1, At, B1); PG8_BAR;
            PG8_LDB(B0, 1, 0); PG8_SCHED; PG8_LDA(At, 1, 0); PG8_STAGE(PG8_SA(0, 1), a2 + hstep, voffA);
            PG8_WAIT_L(8); PG8_BAR; PG8_WAIT_L(0); PG8_MMA(0, 0, At, B0); PG8_BAR; PG8_SCHED;
            PG8_LDB(B1, 1, 1); PG8_STAGE(PG8_SB(1, 0), b3, voffB);
            PG8_BAR; PG8_WAIT_L(0); PG8_MMA(0, 1, At, B1); PG8_BAR;
            PG8_LDA(At, 1, 1); PG8_STAGE(PG8_SA(1, 0), a3, voffA);
            PG8_BAR; PG8_WAIT_L(0); PG8_MMA(1, 0, At, B0); PG8_BAR; PG8_SCHED;
            PG8_STAGE(PG8_SB(1, 1), b3 + hstep, voffB);
            PG8_WAIT_V(6); PG8_BAR; PG8_MMA(1, 1, At, B1); PG8_BAR;
            }
        }
        if constexpr (ALIGN_EPI) { if (wr == 0) PG8_BAR; }
        if constexpr (!Epi::AFTER_DRAIN) { E(acc, cur, wr, wc, fr, fq); S.done(cur); }
        if (!has_next) break;
#pragma unroll
        for (int a = 0; a < 2; ++a)
#pragma unroll
            for (int b = 0; b < 2; ++b)
#pragma unroll
                for (int m = 0; m < 4; ++m)
#pragma unroll
                    for (int n = 0; n < 2; ++n) acc[a][b][m][n] = (f32x4){0.f, 0.f, 0.f, 0.f};
        cur = nxt; cA = nA; cB = nB; ++ui;
        if constexpr (ALIGN_EPI) { if (wr == 1) PG8_BAR; }
    }
    PG8_WAIT_V(0);
    if constexpr (!ALIGN_EPI) { if (wr == 0) PG8_BAR; }
    PG8_BAR;
    if constexpr (Epi::AFTER_DRAIN) { E.fused(acc, cur, wr, wc, fr, fq, lds, wid, lane); S.done(cur); }
#undef PG8_SA
#undef PG8_SB
#undef PG8_STAGE
#undef PG8_LDA
#undef PG8_LDB
#undef PG8_MMA
#undef PG8_WAIT_V
#undef PG8_WAIT_L
#undef PG8_BAR
#undef PG8_SCHED
}
}

typedef pg8::bf16_t bf16_t;
typedef pg8::f32x4 f32x4;
typedef pg8::u32x4 u32x4;
typedef float f32x2 __attribute__((ext_vector_type(2)));
typedef float f32x16 __attribute__((ext_vector_type(16)));
typedef short bf16x8 __attribute__((ext_vector_type(8)));
typedef short s16x4 __attribute__((ext_vector_type(4)));
typedef _Float16 h16x2 __attribute__((ext_vector_type(2)));

constexpr int BATCH = 8, SEQ = 8192, DM = 1024, T = BATCH * SEQ;
constexpr float NORM_EPS = 1e-6f, GN_EPS = 64e-5f;
constexpr size_t MiB = 1u << 20;
constexpr size_t WS_SSQ = 44 * MiB;
constexpr size_t WS_W = 2 * MiB;
constexpr size_t SZ_MWIN = 2304u * 1024 * 2, SZ_MWUQ = 1536u * 768 * 2, SZ_MWUKV = 2048u * 256 * 2, SZ_WOUT = 1024u * 1024 * 2;
constexpr size_t SZ_MLA = SZ_MWIN + SZ_MWUQ + SZ_MWUKV + SZ_WOUT;
constexpr size_t SZ_RWIN = 4352u * 1024 * 2, SZ_RWL = 2048u * 128 * 2;
constexpr size_t SZ_RWKV = SZ_RWIN + SZ_RWL + SZ_WOUT;
static_assert(WS_W + 2 * SZ_MLA + 2 * SZ_RWKV <= 48 * MiB, "weights");
constexpr size_t WS_BUFA = 48 * MiB;
constexpr size_t WS_L = 176 * MiB;
constexpr size_t WS_QLAT = WS_L, WS_KVLAT = WS_L + 96 * MiB, WS_KROPE = WS_L + 128 * MiB, WS_GATE = WS_L + 136 * MiB, WS_Q = WS_L + 264 * MiB,
                 WS_KN = WS_L + 456 * MiB, WS_V = WS_L + 584 * MiB;
constexpr size_t WS_PR = WS_L, WS_LARAW = WS_L + 512 * MiB, WS_LA = WS_L + 544 * MiB, WS_E = WS_L + 560 * MiB, WS_A = WS_L + 688 * MiB;
constexpr size_t WS_SSX = WS_L + 816 * MiB;
constexpr size_t WS_END = WS_SSX + 4 * MiB;
constexpr size_t WS_XF = WS_PR;

constexpr int LDS_BYTES = 131072 + 1024;
constexpr int LDS_MISC = 131072;
constexpr size_t WS_BAR = 0, BAR_BYTES = 16384;
constexpr int NTHREADS = 512;

__device__ const float ROPE_INVF[32] = {
    1.000000000e+00f, 7.498942018e-01f, 5.623413324e-01f, 4.216965139e-01f, 3.162277639e-01f, 2.371373922e-01f, 1.778279394e-01f, 1.333521456e-01f,
    1.000000015e-01f, 7.498941571e-02f, 5.623412877e-02f, 4.216964915e-02f, 3.162277862e-02f, 2.371373586e-02f, 1.778279431e-02f, 1.333521493e-02f,
    9.999999776e-03f, 7.498942316e-03f, 5.623413250e-03f, 4.216964822e-03f, 3.162277862e-03f, 2.371373819e-03f, 1.778279431e-03f, 1.333521446e-03f,
    1.000000047e-03f, 7.498941850e-04f, 5.623413017e-04f, 4.216965463e-04f, 3.162277862e-04f, 2.371373848e-04f, 1.778279402e-04f, 1.333521504e-04f};

__device__ __forceinline__ unsigned cvtpk(float lo, float hi) { return pg8::cvt_pk_bf16(lo, hi); }
__device__ __forceinline__ u32x4 pack8bf(f32x4 a, f32x4 b) { u32x4 w; w.x = cvtpk(a[0], a[1]); w.y = cvtpk(a[2], a[3]); w.z = cvtpk(b[0], b[1]); w.w = cvtpk(b[2], b[3]); return w; }
__device__ __forceinline__ unsigned pkh(float lo, float hi) { h16x2 v = {(_Float16)lo, (_Float16)hi}; return __builtin_bit_cast(unsigned, v); }
__device__ __forceinline__ u32x4 pack8h(f32x4 a, f32x4 b) { u32x4 w; w.x = pkh(a[0], a[1]); w.y = pkh(a[2], a[3]); w.z = pkh(b[0], b[1]); w.w = pkh(b[2], b[3]); return w; }
__device__ __forceinline__ float bf_lo(unsigned w) { return __uint_as_float(w << 16); }
__device__ __forceinline__ float bf_hi(unsigned w) { return __uint_as_float(w & 0xffff0000u); }
__device__ __forceinline__ void unpack8bf(u32x4 w, float* f) { f[0] = bf_lo(w.x); f[1] = bf_hi(w.x); f[2] = bf_lo(w.y); f[3] = bf_hi(w.y); f[4] = bf_lo(w.z); f[5] = bf_hi(w.z); f[6] = bf_lo(w.w); f[7] = bf_hi(w.w); }
__device__ __forceinline__ float h_lo(unsigned w) { return (float)__builtin_bit_cast(_Float16, (unsigned short)(w & 0xffffu)); }
__device__ __forceinline__ float h_hi(unsigned w) { return (float)__builtin_bit_cast(_Float16, (unsigned short)(w >> 16)); }
__device__ __forceinline__ void unpack8h(u32x4 w, float* f) { f[0] = h_lo(w.x); f[1] = h_hi(w.x); f[2] = h_lo(w.y); f[3] = h_hi(w.y); f[4] = h_lo(w.z); f[5] = h_hi(w.z); f[6] = h_lo(w.w); f[7] = h_hi(w.w); }
__device__ __forceinline__ float sigmoidf_(float z) { return __builtin_amdgcn_rcpf(1.f + __expf(-z)); }
__device__ __forceinline__ float siluf_(float z) { return z * sigmoidf_(z); }
__device__ __forceinline__ float wave_sum(float v) {
#pragma unroll
    for (int o = 1; o < 64; o <<= 1) v += __shfl_xor(v, o);
    return v;
}
__device__ __forceinline__ void rope_sc(int pos, int i, float& s, float& c) {
    const float ang = (float)pos * ROPE_INVF[i];
    double rev = (double)ang * 0.15915494309189535;
    rev -= __builtin_floor(rev);
    const float fr = (float)rev;
    s = __builtin_amdgcn_sinf(fr); c = __builtin_amdgcn_cosf(fr);
}
__device__ __forceinline__ void rope8(f32x4& v0, f32x4& v1, int pos, int i0) {
    float s, c, a, b;
    rope_sc(pos, i0, s, c);     a = v0[0]; b = v0[1]; v0[0] = a * c - b * s; v0[1] = b * c + a * s;
    rope_sc(pos, i0 + 1, s, c); a = v0[2]; b = v0[3]; v0[2] = a * c - b * s; v0[3] = b * c + a * s;
    rope_sc(pos, i0 + 2, s, c); a = v1[0]; b = v1[1]; v1[0] = a * c - b * s; v1[1] = b * c + a * s;
    rope_sc(pos, i0 + 3, s, c); a = v1[2]; b = v1[3]; v1[2] = a * c - b * s; v1[3] = b * c + a * s;
}

namespace pg8 {
__device__ __forceinline__ float row_rstd(const float* ssx, int row) {
    const f32x4 s0 = *(const f32x4*)(ssx + (size_t)row * 16), s1 = *(const f32x4*)(ssx + (size_t)row * 16 + 4), s2 = *(const f32x4*)(ssx + (size_t)row * 16 + 8), s3 = *(const f32x4*)(ssx + (size_t)row * 16 + 12);
    const float t = (((s0[0] + s0[1]) + (s0[2] + s0[3])) + ((s1[0] + s1[1]) + (s1[2] + s1[3]))) + (((s2[0] + s2[1]) + (s2[2] + s2[3])) + ((s3[0] + s3[1]) + (s3[2] + s3[3])));
    return __builtin_amdgcn_rsqf(t * (1.0f / 1024.0f) + NORM_EPS);
}
struct EpiMlaIn {
    static constexpr bool PERM = true, AFTER_DRAIN = false;
    unsigned char* ws; const int* pos;
    __device__ __forceinline__ void operator()(const f32x4 (&acc)[2][2][4][2], const Unit& u, int wr, int wc, int fr, int fq) const {
        const int ct = u.pn; const int row0 = u.pm * BM + wr * 64 + fr;
        bf16_t* qlat = (bf16_t*)(ws + WS_QLAT); bf16_t* kvlat = (bf16_t*)(ws + WS_KVLAT); bf16_t* krope = (bf16_t*)(ws + WS_KROPE); bf16_t* gate = (bf16_t*)(ws + WS_GATE); float* ssq = (float*)(ws + WS_SSQ);
#pragma unroll
        for (int ai = 0; ai < 2; ++ai)
#pragma unroll
            for (int m = 0; m < 4; ++m) {
                const int row = row0 + ai * HALF + m * 16;
                const float rs = row_rstd((const float*)(ws + WS_SSX), row);
                if (ct <= 3) {
                    float s = 0.f;
#pragma unroll
                    for (int bj = 0; bj < 2; ++bj) { const f32x4 v0 = acc[ai][bj][m][0] * rs, v1 = acc[ai][bj][m][1] * rs; const int cc = bj * HALF + wc * 32 + 8 * fq;
                        s += (v0[0] * v0[0] + v0[1] * v0[1]) + (v0[2] * v0[2] + v0[3] * v0[3]) + (v1[0] * v1[0] + v1[1] * v1[1]) + (v1[2] * v1[2] + v1[3] * v1[3]);
                        if (ct < 3) *(u32x4*)(qlat + (size_t)row * 768 + ct * 256 + cc) = pack8bf(v0, v1);
                        else *(u32x4*)(kvlat + (size_t)row * 256 + cc) = pack8bf(v0, v1); }
                    s += __shfl_xor(s, 16); s += __shfl_xor(s, 32);
                    if (fq == 0) ssq[(size_t)row * 16 + ct * 4 + wc] = s;
                } else if (ct == 4) {
                    if (wc < 2) { f32x4 v0 = acc[ai][0][m][0] * rs, v1 = acc[ai][0][m][1] * rs; const int cc = wc * 32 + 8 * fq;
                        rope8(v0, v1, pos[row], cc >> 1);
                        *(u32x4*)(krope + (size_t)row * 64 + cc) = pack8bf(v0, v1); }
                } else {
#pragma unroll
                    for (int bj = 0; bj < 2; ++bj) { f32x4 v0 = acc[ai][bj][m][0] * rs, v1 = acc[ai][bj][m][1] * rs; const int cc = bj * HALF + wc * 32 + 8 * fq;
#pragma unroll
                        for (int e = 0; e < 4; ++e) { v0[e] = siluf_(v0[e]); v1[e] = siluf_(v1[e]); }
                        *(u32x4*)(gate + (size_t)row * 1024 + (ct - 5) * 256 + cc) = pack8bf(v0, v1); }
                }
            }
    }
};
struct EpiUq {
    static constexpr bool PERM = true, AFTER_DRAIN = false;
    unsigned char* ws; const int* pos;
    __device__ __forceinline__ void operator()(const f32x4 (&acc)[2][2][4][2], const Unit& u, int wr, int wc, int fr, int fq) const {
        const int ct = u.pn; const int row0 = u.pm * BM + wr * 64 + fr; bf16_t* q = (bf16_t*)(ws + WS_Q); const float* ssq = (const float*)(ws + WS_SSQ);
#pragma unroll
        for (int ai = 0; ai < 2; ++ai)
#pragma unroll
            for (int m = 0; m < 4; ++m) {
                const int row = row0 + ai * HALF + m * 16;
                float ssum;
                { const f32x4 s0 = *(const f32x4*)(ssq + (size_t)row * 16), s1 = *(const f32x4*)(ssq + (size_t)row * 16 + 4), s2 = *(const f32x4*)(ssq + (size_t)row * 16 + 8);
                  ssum = (((s0[0] + s0[1]) + (s0[2] + s0[3])) + ((s1[0] + s1[1]) + (s1[2] + s1[3]))) + ((s2[0] + s2[1]) + (s2[2] + s2[3])); }
                const float rs = __builtin_amdgcn_rsqf(ssum * (1.0f / 768.0f) + NORM_EPS);
                int ps = 0; if (ct >= 4) ps = pos[row];
#pragma unroll
                for (int bj = 0; bj < 2; ++bj) { f32x4 v0 = acc[ai][bj][m][0] * rs, v1 = acc[ai][bj][m][1] * rs; const int cc = bj * HALF + wc * 32 + 8 * fq;
                    if (ct < 4) { const int col = ct * 256 + cc, h = col >> 7, d = col & 127;
                        *(u32x4*)(q + (size_t)row * 1536 + h * 192 + d) = pack8bf(v0, v1); }
                    else { const int col = (ct - 4) * 256 + cc, h = col >> 6, p = col & 63;
                        rope8(v0, v1, ps, p >> 1);
                        *(u32x4*)(q + (size_t)row * 1536 + h * 192 + 128 + p) = pack8bf(v0, v1); } }
            }
    }
};
struct EpiUkv {
    static constexpr bool PERM = true, AFTER_DRAIN = false;
    unsigned char* ws;
    __device__ __forceinline__ void operator()(const f32x4 (&acc)[2][2][4][2], const Unit& u, int wr, int wc, int fr, int fq) const {
        const int row0 = u.pm * BM + wr * 64 + fr; bf16_t* kn = (bf16_t*)(ws + WS_KN); bf16_t* v = (bf16_t*)(ws + WS_V); const float* ssq = (const float*)(ws + WS_SSQ);
#pragma unroll
        for (int ai = 0; ai < 2; ++ai)
#pragma unroll
            for (int m = 0; m < 4; ++m) {
                const int row = row0 + ai * HALF + m * 16;
                const f32x4 s3 = *(const f32x4*)(ssq + (size_t)row * 16 + 12);
                const float rs = __builtin_amdgcn_rsqf(((s3[0] + s3[1]) + (s3[2] + s3[3])) * (1.0f / 256.0f) + NORM_EPS);
                const size_t off = (size_t)row * 1024 + u.pn * 128 + wc * 32 + 8 * fq;
                *(u32x4*)(kn + off) = pack8bf(acc[ai][0][m][0] * rs, acc[ai][0][m][1] * rs);
                *(u32x4*)(v + off) = pack8bf(acc[ai][1][m][0] * rs, acc[ai][1][m][1] * rs);
            }
    }
};
struct EpiResid {
    static constexpr bool PERM = true, AFTER_DRAIN = false;
    bf16_t* xb; float* ssx; float* xf;
    __device__ __forceinline__ void operator()(const f32x4 (&acc)[2][2][4][2], const Unit& u, int wr, int wc, int fr, int fq) const {
        const int row0 = u.pm * BM + wr * 64 + fr;
#pragma unroll
        for (int ai = 0; ai < 2; ++ai)
#pragma unroll
            for (int m = 0; m < 4; ++m) { const int row = row0 + ai * HALF + m * 16; float s = 0.f;
#pragma unroll
                for (int bj = 0; bj < 2; ++bj) { const size_t off = (size_t)row * DM + u.pn * BM + bj * HALF + wc * 32 + 8 * fq;
                    const u32x4 xw = *(const u32x4*)(xb + off);
                    f32x4 v0 = acc[ai][bj][m][0], v1 = acc[ai][bj][m][1];
                    v0[0] += bf_lo(xw.x); v0[1] += bf_hi(xw.x); v0[2] += bf_lo(xw.y); v0[3] += bf_hi(xw.y); v1[0] += bf_lo(xw.z); v1[1] += bf_hi(xw.z); v1[2] += bf_lo(xw.w); v1[3] += bf_hi(xw.w);
                    if (xf) { *(f32x4*)(xf + off) = v0; *(f32x4*)(xf + off + 4) = v1; }
                    else { const u32x4 ow = pack8bf(v0, v1); *(u32x4*)(xb + off) = ow;
                        const float a0 = bf_lo(ow.x), a1 = bf_hi(ow.x), a2 = bf_lo(ow.y), a3 = bf_hi(ow.y), a4 = bf_lo(ow.z), a5 = bf_hi(ow.z), a6 = bf_lo(ow.w), a7 = bf_hi(ow.w);
                        s += ((a0 * a0 + a1 * a1) + (a2 * a2 + a3 * a3)) + ((a4 * a4 + a5 * a5) + (a6 * a6 + a7 * a7)); } }
                if (!xf) { s += __shfl_xor(s, 16); s += __shfl_xor(s, 32); if (fq == 0) ssx[(size_t)row * 16 + u.pn * 4 + wc] = s; } }
    }
};
struct EpiRwkvIn {
    static constexpr bool PERM = true, AFTER_DRAIN = false;
    unsigned char* ws;
    __device__ __forceinline__ void operator()(const f32x4 (&acc)[2][2][4][2], const Unit& u, int wr, int wc, int fr, int fq) const {
        const int ct = u.pn; const int row0 = u.pm * BM + wr * 64 + fr; bf16_t* pr = (bf16_t*)(ws + WS_PR); float* laraw = (float*)(ws + WS_LARAW);
#pragma unroll
        for (int ai = 0; ai < 2; ++ai)
#pragma unroll
            for (int m = 0; m < 4; ++m) {
                const int row = row0 + ai * HALF + m * 16;
                const float rs = row_rstd((const float*)(ws + WS_SSX), row);
                if (ct < 16) {
#pragma unroll
                    for (int bj = 0; bj < 2; ++bj) { const int cc = bj * HALF + wc * 32 + 8 * fq; *(u32x4*)(pr + (size_t)row * 4096 + ct * 256 + cc) = pack8bf(acc[ai][bj][m][0] * rs, acc[ai][bj][m][1] * rs); }
                } else { const int cc = wc * 32 + 8 * fq; float* d = laraw + (size_t)row * 128 + cc; *(f32x4*)d = acc[ai][0][m][0] * rs; *(f32x4*)(d + 4) = acc[ai][0][m][1] * rs; }
            }
    }
};
struct EpiLora {
    static constexpr bool PERM = true, AFTER_DRAIN = false;
    unsigned char* ws; const float* w0; const float* a0;
    __device__ __forceinline__ void operator()(const f32x4 (&acc)[2][2][4][2], const Unit& u, int wr, int wc, int fr, int fq) const {
        const int ct = u.pn; const int row0 = u.pm * BM + wr * 64 + fr; _Float16* E = (_Float16*)(ws + WS_E); _Float16* A = (_Float16*)(ws + WS_A);
        const bool isw = ct < 4; const float* bias = isw ? w0 : a0; _Float16* dst = isw ? E : A; const float mul = isw ? 0.6065306597126334f : 1.0f;
        const int cb = (isw ? ct : ct - 4) * 256 + wc * 32 + 8 * fq;
#pragma unroll
        for (int bj = 0; bj < 2; ++bj) { const int c = cb + bj * HALF;
            const f32x4 b0 = *(const f32x4*)(bias + c), b1 = *(const f32x4*)(bias + c + 4);
#pragma unroll
            for (int ai = 0; ai < 2; ++ai)
#pragma unroll
                for (int m = 0; m < 4; ++m) { const int row = row0 + ai * HALF + m * 16;
                    f32x4 v0 = acc[ai][bj][m][0] + b0, v1 = acc[ai][bj][m][1] + b1;
#pragma unroll
                    for (int e = 0; e < 4; ++e) { v0[e] = sigmoidf_(v0[e]) * mul; v1[e] = sigmoidf_(v1[e]) * mul; }
                    *(u32x4*)(dst + (size_t)row * 1024 + c) = pack8h(v0, v1); } }
    }
};
}

#define LASF __attribute__((address_space(3)))
__device__ __forceinline__ int il64(int i) { return 2 * (i & 31) + (i >> 5); }
__device__ __forceinline__ int rowmap(int mode, int n) {
    if (mode == 1) return n < 1024 ? n : (n < 1088 ? 1024 + il64(n - 1024) : n + 192);
    if (mode == 2) { const int h = n / 192, w = n - h * 192; return w < 128 ? h * 128 + w : 1024 + h * 64 + il64(w - 128); }
    if (mode == 3) return n + 1024;
    return n;
}
__device__ __forceinline__ void transpose_item(const float* W, int N, bf16_t* WT, int ldk, float* scr, int item, int lane, const float* kscale, float gscale, int mode) {
    const int nblk = N / 32, kb = item / nblk, nb = item - kb * nblk, k0 = 64 * kb, n0 = 32 * nb;
#pragma unroll 8
    for (int i = 0; i < 32; ++i) { const int kk = 2 * i + (lane >> 5); const float sc = kscale ? kscale[k0 + kk] * gscale : gscale;
        scr[kk * 33 + (lane & 31)] = W[(size_t)(k0 + kk) * N + n0 + (lane & 31)] * sc; }
    asm volatile("s_waitcnt lgkmcnt(0)" ::: "memory");
    const int c = lane & 7;
#pragma unroll
    for (int j = 0; j < 4; ++j) { const int n = (lane >> 3) + 8 * j; const float* s = scr + (8 * c) * 33 + n;
        u32x4 o; o.x = cvtpk(s[0 * 33], s[1 * 33]); o.y = cvtpk(s[2 * 33], s[3 * 33]); o.z = cvtpk(s[4 * 33], s[5 * 33]); o.w = cvtpk(s[6 * 33], s[7 * 33]);
        *(u32x4*)(WT + (size_t)rowmap(mode, n0 + n) * ldk + k0 + 8 * c) = o; }
    asm volatile("s_waitcnt lgkmcnt(0)" ::: "memory");
}
struct Args { const void* in[22]; float* out; unsigned char* ws; int ph_lo, ph_hi; };

template <class AP> __device__ __forceinline__ void prep_weights(AP ap, unsigned char* lds, int wave, int lane, int gw, int ngw) {
    float* scr = (float*)(lds + wave * 16384);
    constexpr int PER = 5088;
    const float QSCALE = 0.07216878364870322f * 1.4426950408889634f;
#pragma nounroll
    for (int it = gw; it < 2 * PER; it += ngw) {
        const int j = it / PER; int r = it - j * PER;
        unsigned char* mb = ap->ws + WS_W + (size_t)j * SZ_MLA; unsigned char* rb = ap->ws + WS_W + 2 * SZ_MLA + (size_t)j * SZ_RWKV;
        const float* W; int N; bf16_t* WT; int ldk; const float* ks = nullptr; float gs = 1.f; int mode = 0;
        if (r < 1056) { W = (const float*)ap->in[3] + (size_t)j * 1024 * 2112; N = 2112; WT = (bf16_t*)mb; ldk = 1024; ks = (const float*)ap->in[2] + (2 * j) * 1024; mode = 1; }
        else if ((r -= 1056) < 576) { W = (const float*)ap->in[5] + (size_t)j * 768 * 1536; N = 1536; WT = (bf16_t*)(mb + SZ_MWIN); ldk = 768; ks = (const float*)ap->in[4] + j * 768; gs = QSCALE; mode = 2; }
        else if ((r -= 576) < 256) { W = (const float*)ap->in[7] + (size_t)j * 256 * 2048; N = 2048; WT = (bf16_t*)(mb + SZ_MWIN + SZ_MWUQ); ldk = 256; ks = (const float*)ap->in[6] + j * 256; }
        else if ((r -= 256) < 512) { W = (const float*)ap->in[8] + (size_t)j * 1024 * 1024; N = 1024; WT = (bf16_t*)(mb + SZ_MWIN + SZ_MWUQ + SZ_MWUKV); ldk = 1024; }
        else if ((r -= 512) < 2112) { W = (const float*)ap->in[9] + (size_t)j * 1024 * 4224; N = 4224; WT = (bf16_t*)rb; ldk = 1024; ks = (const float*)ap->in[2] + (2 * j + 1) * 1024; }
        else if ((r -= 2112) < 32) { W = (const float*)ap->in[12] + (size_t)j * 64 * 1024; N = 1024; WT = (bf16_t*)(rb + SZ_RWIN); ldk = 128; }
        else if ((r -= 32) < 32) { W = (const float*)ap->in[14] + (size_t)j * 64 * 1024; N = 1024; WT = (bf16_t*)(rb + SZ_RWIN) + 64; ldk = 128; mode = 3; }
        else { r -= 32; W = (const float*)ap->in[20] + (size_t)j * 1024 * 1024; N = 1024; WT = (bf16_t*)(rb + SZ_RWIN + SZ_RWL); ldk = 1024; }
        transpose_item(W, N, WT, ldk, scr, r, lane, ks, gs, mode);
    }
    const int gt = gw * 64 + lane, ngt = ngw * 64;
    constexpr int Z0 = 24576, Z1 = 16384, Z2 = 16384, ZT = Z0 + Z1 + Z2;
    unsigned zz = 0u; asm volatile("" : "+v"(zz)); const u32x4 z = {zz, zz, zz, zz};
    for (int it = gt; it < 2 * ZT; it += ngt) {
        const int j = it / ZT; int r = it - j * ZT;
        unsigned char* mb = ap->ws + WS_W + (size_t)j * SZ_MLA; unsigned char* rb = ap->ws + WS_W + 2 * SZ_MLA + (size_t)j * SZ_RWKV;
        if (r < Z0) *(u32x4*)(mb + (size_t)1088 * 2048 + (size_t)r * 16) = z;
        else if ((r -= Z0) < Z1) *(u32x4*)(rb + (size_t)4224 * 2048 + (size_t)r * 16) = z;
        else { r -= Z1; const int row = r >> 3, u = r & 7; *(u32x4*)(rb + SZ_RWIN + (size_t)row * 256 + (row < 1024 ? 128 : 0) + u * 16) = z; }
    }
}

__device__ __forceinline__ void conv_rows_bf16(const float* X, bf16_t* XB, float* ssx, int gw, int ngw, int lane) {
    f32x4 cur[4], nxt[4];
    if (gw < T) {
#pragma unroll
        for (int j = 0; j < 4; ++j) cur[j] = ((const f32x4*)(X + (size_t)gw * DM) + lane)[64 * j]; }
    for (int m = gw; m < T; m += ngw) {
        const int mn = m + ngw < T ? m + ngw : m;
#pragma unroll
        for (int j = 0; j < 4; ++j) nxt[j] = ((const f32x4*)(X + (size_t)mn * DM) + lane)[64 * j];
        unsigned long long* o8 = (unsigned long long*)(XB + (size_t)m * DM) + lane; float s = 0.f;
#pragma unroll
        for (int j = 0; j < 4; ++j) { const f32x4 v = cur[j]; const unsigned w0 = cvtpk(v[0], v[1]), w1 = cvtpk(v[2], v[3]);
            const float a0 = bf_lo(w0), a1 = bf_hi(w0), a2 = bf_lo(w1), a3 = bf_hi(w1); s += (a0 * a0 + a1 * a1) + (a2 * a2 + a3 * a3);
            o8[64 * j] = (unsigned long long)w0 | ((unsigned long long)w1 << 32); }
        s = wave_sum(s);
        if (lane < 16) ssx[(size_t)m * 16 + lane] = lane == 0 ? s : 0.f;
#pragma unroll
        for (int j = 0; j < 4; ++j) cur[j] = nxt[j];
    }
}
__device__ __forceinline__ void final_norm(const float* X, float* out, const float* g, int gw, int ngw, int lane) {
    f32x4 gv[4], cur[4], nxt[4];
#pragma unroll
    for (int j = 0; j < 4; ++j) gv[j] = ((const f32x4*)g)[lane + 64 * j];
    if (gw < T) {
#pragma unroll
        for (int j = 0; j < 4; ++j) cur[j] = ((const f32x4*)(X + (size_t)gw * DM) + lane)[64 * j]; }
    for (int m = gw; m < T; m += ngw) {
        const int mn = m + ngw < T ? m + ngw : m;
#pragma unroll
        for (int j = 0; j < 4; ++j) nxt[j] = ((const f32x4*)(X + (size_t)mn * DM) + lane)[64 * j];
        f32x4* orow = (f32x4*)(out + (size_t)m * DM) + lane; float s = 0.f;
#pragma unroll
        for (int j = 0; j < 4; ++j) s += (cur[j][0] * cur[j][0] + cur[j][1] * cur[j][1]) + (cur[j][2] * cur[j][2] + cur[j][3] * cur[j][3]);
        const float rstd = 1.0f / sqrtf(wave_sum(s) * (1.f / DM) + NORM_EPS);
#pragma unroll
        for (int j = 0; j < 4; ++j) orow[64 * j] = cur[j] * rstd * gv[j];
#pragma unroll
        for (int j = 0; j < 4; ++j) cur[j] = nxt[j];
    }
}

namespace att {
constexpr int KP = 400, KBUF = 64 * KP, VBUF = 16384;
constexpr int OFF_K = 0, OFF_V = 2 * KBUF, OFF_WS = OFF_V + 2 * VBUF, ATT_LDS = OFF_WS + 8 * 64 * 4;
static_assert(ATT_LDS <= 131072, "attention LDS");
constexpr float THR2 = 11.0f;
#define SBAR() __builtin_amdgcn_sched_barrier(0)
__device__ __forceinline__ int v_st(int k, int c) { const int kk = (k & ~0xC) | ((k & 4) << 1) | ((k & 8) >> 1); return ((kk >> 3) * 4 + (c >> 5)) * 512 + ((kk & 7) * 32 + (c & 31)) * 2; }
__device__ __forceinline__ int v_rd_base(int lane) { return ((lane & 3) << 3) | (((lane >> 2) & 3) << 6) | (((lane >> 4) & 1) << 5) | (((lane >> 5) & 1) << 8); }
constexpr int v_rd_off(int d0, int ks, int half) { return d0 * 512 + ks * 4096 + half * 2048; }
__device__ __forceinline__ int crow(int r, int hi) { return (r & 3) + 8 * (r >> 2) + 4 * hi; }

__device__ __forceinline__ void mask_tile(f32x16& p0, f32x16& p1, int dq) {
    const float NEG = -__builtin_inff();
#pragma unroll
    for (int r = 0; r < 16; ++r) {
        const int c = (r & 3) + 8 * (r >> 2);
        if (dq - c < 0) p0[r] = NEG;
        if (dq - c - 32 < 0) p1[r] = NEG;
    }
}
__device__ __forceinline__ void softmax_tile(f32x16& p0, f32x16& p1, float& m_reg, float& l_reg, float& alpha, bf16x8& pa0, bf16x8& pa1, bf16x8& pa2, bf16x8& pa3) {
    float pmax = p0[0];
#pragma unroll
    for (int r = 1; r < 16; ++r) pmax = fmaxf(pmax, p0[r]);
#pragma unroll
    for (int r = 0; r < 16; ++r) pmax = fmaxf(pmax, p1[r]);
    { auto rr = __builtin_amdgcn_permlane32_swap(__float_as_uint(pmax), __float_as_uint(pmax), false, false);
      pmax = fmaxf(__uint_as_float(rr[0]), __uint_as_float(rr[1])); }
    float mn;
    if (__builtin_expect(__all((pmax - m_reg) <= THR2), 1)) { mn = m_reg; alpha = 1.f; }
    else { mn = fmaxf(m_reg, pmax); alpha = __builtin_amdgcn_exp2f(m_reg - mn); m_reg = mn; }
#pragma unroll
    for (int r = 0; r < 16; ++r) p0[r] = __builtin_amdgcn_exp2f(p0[r] - mn);
#pragma unroll
    for (int r = 0; r < 16; ++r) p1[r] = __builtin_amdgcn_exp2f(p1[r] - mn);
    f32x2 ps2 = {0.f, 0.f};
#pragma unroll
    for (int r = 0; r < 16; r += 2) { ps2 += (f32x2){p0[r], p0[r + 1]}; ps2 += (f32x2){p1[r], p1[r + 1]}; }
    float ps = ps2[0] + ps2[1];
    { auto rr = __builtin_amdgcn_permlane32_swap(__float_as_uint(ps), __float_as_uint(ps), false, false);
      ps = __uint_as_float(rr[0]) + __uint_as_float(rr[1]); }
    l_reg = l_reg * alpha + ps;
#define PK4(P, B_, OUT) do { unsigned a0 = cvtpk(P[B_+0], P[B_+1]), a1 = cvtpk(P[B_+2], P[B_+3]);                          \
        unsigned b0 = cvtpk(P[B_+4], P[B_+5]), b1 = cvtpk(P[B_+6], P[B_+7]);                                             \
        auto r0 = __builtin_amdgcn_permlane32_swap(a0, b0, false, false); auto r1 = __builtin_amdgcn_permlane32_swap(a1, b1, false, false); \
        u32x4 w = {r0[0], r1[0], r0[1], r1[1]}; OUT = *reinterpret_cast<bf16x8*>(&w); } while (0)
    PK4(p0, 0, pa0); PK4(p0, 8, pa1); PK4(p1, 0, pa2); PK4(p1, 8, pa3);
#undef PK4
}
template <int KB>
__device__ __forceinline__ void qkt(f32x16& p0, f32x16& p1, const char* K_lds, int r32, int hi, const bf16x8* qr) {
    p0 = f32x16{}; p1 = f32x16{};
    const int kaddr = (int)(uintptr_t)K_lds + r32 * KP + hi * 16;
    bf16x8 f0, f1, f2, f3;
#define KRD(dst, i) asm volatile("ds_read_b128 %0, %1 offset:%2" : "=v"(dst) : "v"(kaddr), "i"(KB * KBUF + ((i) >> 1) * 32 + ((i) & 1) * 32 * KP) : "memory")
#define KMM(f, i, W) do { asm volatile("s_waitcnt lgkmcnt(%1)" : "+v"(f) : "n"(W) : "memory"); \
        if ((i) & 1) p1 = __builtin_amdgcn_mfma_f32_32x32x16_bf16(f, qr[(i) >> 1], p1, 0, 0, 0); else p0 = __builtin_amdgcn_mfma_f32_32x32x16_bf16(f, qr[(i) >> 1], p0, 0, 0, 0); \
        if ((i) + 4 < 24) KRD(f, (i) + 4); } while (0)
    KRD(f0, 0); KRD(f1, 1); KRD(f2, 2); KRD(f3, 3);
    KMM(f0, 0, 3); KMM(f1, 1, 3); KMM(f2, 2, 3); KMM(f3, 3, 3); KMM(f0, 4, 3); KMM(f1, 5, 3); KMM(f2, 6, 3); KMM(f3, 7, 3);
    KMM(f0, 8, 3); KMM(f1, 9, 3); KMM(f2, 10, 3); KMM(f3, 11, 3); KMM(f0, 12, 3); KMM(f1, 13, 3); KMM(f2, 14, 3); KMM(f3, 15, 3);
    KMM(f0, 16, 3); KMM(f1, 17, 3); KMM(f2, 18, 3); KMM(f3, 19, 3); KMM(f0, 20, 3); KMM(f1, 21, 2); KMM(f2, 22, 1); KMM(f3, 23, 0);
#undef KMM
#undef KRD
}
template <int VB>
__device__ __forceinline__ void pv_tile(f32x16* o, int vb0, bf16x8 pa0, bf16x8 pa1, bf16x8 pa2, bf16x8 pa3) {
#define TRRD(dst, off) asm volatile("ds_read_b64_tr_b16 %0, %1 offset:%2" : "=v"(dst) : "v"(vb0), "i"(off) : "memory")
#define PV_RD(S, d0) do { constexpr int b_ = VB * VBUF + v_rd_off(d0, 0, 0); \
        TRRD(S##l0, b_); TRRD(S##h0, b_ + 2048); TRRD(S##l1, b_ + 4096); TRRD(S##h1, b_ + 6144); TRRD(S##l2, b_ + 8192); TRRD(S##h2, b_ + 10240); TRRD(S##l3, b_ + 12288); TRRD(S##h3, b_ + 14336); } while (0)
#define PV_MM(S, d0, W) do { asm volatile("s_waitcnt lgkmcnt(%8)" : "+v"(S##l0), "+v"(S##h0), "+v"(S##l1), "+v"(S##h1), "+v"(S##l2), "+v"(S##h2), "+v"(S##l3), "+v"(S##h3) : "n"(W) : "memory"); \
        o[d0] = __builtin_amdgcn_mfma_f32_32x32x16_bf16(pa0, (bf16x8){S##l0[0], S##l0[1], S##l0[2], S##l0[3], S##h0[0], S##h0[1], S##h0[2], S##h0[3]}, o[d0], 0, 0, 0);   \
        o[d0] = __builtin_amdgcn_mfma_f32_32x32x16_bf16(pa1, (bf16x8){S##l1[0], S##l1[1], S##l1[2], S##l1[3], S##h1[0], S##h1[1], S##h1[2], S##h1[3]}, o[d0], 0, 0, 0);   \
        o[d0] = __builtin_amdgcn_mfma_f32_32x32x16_bf16(pa2, (bf16x8){S##l2[0], S##l2[1], S##l2[2], S##l2[3], S##h2[0], S##h2[1], S##h2[2], S##h2[3]}, o[d0], 0, 0, 0);   \
        o[d0] = __builtin_amdgcn_mfma_f32_32x32x16_bf16(pa3, (bf16x8){S##l3[0], S##l3[1], S##l3[2], S##l3[3], S##h3[0], S##h3[1], S##h3[2], S##h3[3]}, o[d0], 0, 0, 0); } while (0)
    s16x4 Al0, Al1, Al2, Al3, Ah0, Ah1, Ah2, Ah3, Bl0, Bl1, Bl2, Bl3, Bh0, Bh1, Bh2, Bh3;
    PV_RD(A, 0); PV_RD(B, 1);
    PV_MM(A, 0, 8); PV_RD(A, 2);
    PV_MM(B, 1, 8); PV_RD(B, 3);
    PV_MM(A, 2, 8);
    PV_MM(B, 3, 0);
#undef PV_MM
#undef PV_RD
#undef TRRD
}
__device__ __forceinline__ void attn_unit(int b, int h, int qb, const bf16_t* Q, const bf16_t* KN, const bf16_t* KR, const bf16_t* V, const bf16_t* G, bf16_t* O, char* lds) {
    int tid_ = threadIdx.x; asm volatile("" : "+v"(tid_));
    const int tid = tid_, wid = __builtin_amdgcn_readfirstlane(tid >> 6), lane = tid & 63, r32 = lane & 31, hi = lane >> 5;
    const size_t rowbase = (size_t)b * SEQ; const int q0 = qb * 256;
    char* V_lds = lds + OFF_V; char* K_lds = lds + OFF_K;
    float* wsf = (float*)(lds + OFF_WS) + wid * 64; float* li_l = wsf; float* al_l = wsf + 32;
    const int NT = (q0 + 256) / 64;
    const int qlo = q0 + wid * 32, qm = qlo + r32 - 4 * hi;
    const int sr = tid >> 4, sc = (tid & 15) * 8, vst0 = v_st(sr, sc), vst1 = v_st(32 + sr, sc), kws = sr * KP + sc * 2;
    const int rr = tid >> 3, rc = (tid & 7) * 8, krs = rr * KP + 256 + rc * 2;
    const int vb0 = (int)(uintptr_t)V_lds + v_rd_base(lane);
    const bf16_t* Kh = KN + rowbase * 1024 + h * 128 + sc; const bf16_t* Vh = V + rowbase * 1024 + h * 128 + sc; const bf16_t* Rh = KR + rowbase * 64 + rc;
    bf16x8 qr[12];
    { const bf16_t* qp = Q + (rowbase + qlo + r32) * 1536 + h * 192 + hi * 8;
#pragma unroll
      for (int d0 = 0; d0 < 12; ++d0) qr[d0] = *reinterpret_cast<const bf16x8*>(qp + d0 * 16); }
    bf16x8 sk0, sk1, skr, sv0, sv1;
#define LOADG(t) do { const size_t k0_ = (size_t)(t) * 64; sk0 = *(const bf16x8*)(Kh + (k0_ + sr) * 1024); sk1 = *(const bf16x8*)(Kh + (k0_ + 32 + sr) * 1024); \
        skr = *(const bf16x8*)(Rh + (k0_ + rr) * 64); sv0 = *(const bf16x8*)(Vh + (k0_ + sr) * 1024); sv1 = *(const bf16x8*)(Vh + (k0_ + 32 + sr) * 1024); } while (0)
#define WRITEL(bf) do { *(bf16x8*)(K_lds + (bf) * KBUF + kws) = sk0; *(bf16x8*)(K_lds + (bf) * KBUF + kws + 32 * KP) = sk1; *(bf16x8*)(K_lds + (bf) * KBUF + krs) = skr; \
        *(bf16x8*)(V_lds + (bf) * VBUF + vst0) = sv0; *(bf16x8*)(V_lds + (bf) * VBUF + vst1) = sv1; } while (0)
    float m_reg = -1e30f, l_reg = 0.f; f32x16 o[4] = {};
    f32x16 p0, p1; bf16x8 pa0, pa1, pa2, pa3; float alpha;
    LOADG(0); WRITEL(0); LOADG(1); __syncthreads();
#define STEP(BUF, t) do { \
        if ((t) + 1 < NT) WRITEL((BUF) ^ 1); \
        if ((t) + 2 < NT) LOADG((t) + 2); \
        SBAR(); __builtin_amdgcn_s_setprio(1); qkt<BUF>(p0, p1, K_lds, r32, hi, qr); __builtin_amdgcn_s_setprio(0); \
        { const int kb_ = (t) * 64; if (kb_ + 63 > qlo) mask_tile(p0, p1, qm - kb_); } \
        softmax_tile(p0, p1, m_reg, l_reg, alpha, pa0, pa1, pa2, pa3); \
        if (__any(alpha < 1.f)) { if (hi == 0) al_l[r32] = alpha; asm volatile("s_waitcnt lgkmcnt(0)" ::: "memory"); \
            _Pragma("unroll") for (int d_ = 0; d_ < 4; ++d_) _Pragma("unroll") for (int r = 0; r < 16; ++r) o[d_][r] *= al_l[crow(r, hi)]; } \
        SBAR(); __builtin_amdgcn_s_setprio(1); pv_tile<BUF>(o, vb0, pa0, pa1, pa2, pa3); __builtin_amdgcn_s_setprio(0); \
        __syncthreads(); } while (0)
    for (int t = 0; t < NT; t += 2) { STEP(0, t); STEP(1, t + 1); }
#undef STEP
#undef LOADG
#undef WRITEL
    if (hi == 0) li_l[r32] = l_reg; asm volatile("s_waitcnt lgkmcnt(0)" ::: "memory");
    const size_t obase = (rowbase + qlo) * 1024 + h * 128 + r32;
#pragma unroll
    for (int r = 0; r < 16; ++r) { const int orow = crow(r, hi); const float rli = __builtin_amdgcn_rcpf(li_l[orow]);
#pragma unroll
        for (int d0 = 0; d0 < 4; ++d0) { const size_t off = obase + (size_t)orow * 1024 + d0 * 32;
            const float gv = __uint_as_float(((unsigned)G[off]) << 16);
            const float v = o[d0][r] * rli * gv; const float vn = __shfl_xor(v, 1);
            if ((r32 & 1) == 0) *(unsigned*)(O + off) = cvtpk(v, vn); } }
    __syncthreads();
}
__device__ __forceinline__ void attn_phase(unsigned char* ws, char* lds, int vcu, int G_) {
    const bf16_t* Q = (const bf16_t*)(ws + WS_Q); const bf16_t* KN = (const bf16_t*)(ws + WS_KN); const bf16_t* KR = (const bf16_t*)(ws + WS_KROPE); const bf16_t* V = (const bf16_t*)(ws + WS_V); const bf16_t* G = (const bf16_t*)(ws + WS_GATE); bf16_t* O = (bf16_t*)(ws + WS_BUFA);
    for (int L = vcu; L < 1024; L += G_) { const int bh = L >> 4, x = L & 15;
        attn_unit(bh >> 3, bh & 7, 31 - x, Q, KN, KR, V, G, O, lds);
        attn_unit(bh >> 3, bh & 7, x, Q, KN, KR, V, G, O, lds); }
}
#undef SBAR
}

__device__ __forceinline__ float tanhf_(float x) { return 1.f - 2.f * __builtin_amdgcn_rcpf(__expf(2.f * x) + 1.f); }
__device__ __forceinline__ void lora_in_phase(const float* laraw, const float* mu  , bf16_t* la, int gt, int ngt) {
    for (int idx = gt; idx < T * 16; idx += ngt) {
        const int t = idx >> 4, g = idx & 15, c0 = g * 8; const int s = t & (SEQ - 1);
        const float* p = laraw + (size_t)t * 128 + c0;
        f32x4 r0 = *(const f32x4*)p, r1 = *(const f32x4*)(p + 4), q0 = {0.f, 0.f, 0.f, 0.f}, q1 = q0;
        if (s > 0) { q0 = *(const f32x4*)(p - 128); q1 = *(const f32x4*)(p - 124); }
        const f32x4 m0 = *(const f32x4*)(mu + 4096 + c0), m1 = *(const f32x4*)(mu + 4096 + c0 + 4);
        f32x4 v0 = r0 + m0 * (q0 - r0), v1 = r1 + m1 * (q1 - r1);
        if (g < 8) {
#pragma unroll
            for (int e = 0; e < 4; ++e) { v0[e] = tanhf_(v0[e]); v1[e] = tanhf_(v1[e]); } }
        *(u32x4*)(la + (size_t)t * 128 + c0) = pack8bf(v0, v1);
    }
}
namespace scan {
constexpr int STEP_F = 356, STEPB = STEP_F * 4, CH = 32, BUFB = CH * STEPB, OFF_Y = 2 * BUFB, YB = CH * 32 * 4, OFF_YD = OFF_Y + 2 * YB  , SCAN_LDS = OFF_YD + 512 * 4;
static_assert(SCAN_LDS <= 131072, "scan LDS");
template <int CTRL> __device__ __forceinline__ float dpp_add(float x) {
    return x + __builtin_bit_cast(float, __builtin_amdgcn_update_dpp(0, __builtin_bit_cast(int, x), CTRL, 0xf, 0xf, true));
}
__device__ __forceinline__ float allred16(float x) { x = dpp_add<0xB1>(x); x = dpp_add<0x4E>(x); x = dpp_add<0x141>(x); x = dpp_add<0x140>(x); return x; }

__device__ __forceinline__ void scan_item(int item, unsigned char* ws, const float* mu, const float* k_k, const float* k_a, const float* r_k, char* lds) {
    const bf16_t* PR = (const bf16_t*)(ws + WS_PR); const _Float16* E = (const _Float16*)(ws + WS_E); const _Float16* A = (const _Float16*)(ws + WS_A); bf16_t* Y = (bf16_t*)(ws + WS_BUFA); float* BON = (float*)(ws + WS_SSQ);
    int tid_ = threadIdx.x; asm volatile("" : "+v"(tid_));
    const int tid = tid_, wid = __builtin_amdgcn_readfirstlane(tid >> 6), lane = tid & 63;
    const int bh = item >> 1, half = item & 1, b = bh >> 4, h = bh & 15;
    const size_t rowbase = (size_t)b * SEQ;
    constexpr int NCH = SEQ / CH;
    typedef unsigned u32x2 __attribute__((ext_vector_type(2)));
    const int ls = tid >> 4, lq = tid & 15, c0 = h * 64 + lq * 4;
    const f32x4 mr = *(const f32x4*)(mu + c0), mk = *(const f32x4*)(mu + 1024 + c0), mv = *(const f32x4*)(mu + 2048 + c0), kkp = *(const f32x4*)(k_k + c0), kap = *(const f32x4*)(k_a + c0), rkp = *(const f32x4*)(r_k + c0);
    const bool myv = (lq >> 3) == half;
    u32x2 g_rt, g_kt, g_vt, g_rp, g_kp, g_vp, g_et, g_at;
#define SC_LOAD(cn) do { const int sg_ = (cn) * CH + ls; const bf16_t* pr_ = PR + (rowbase + sg_) * 4096 + c0; \
        g_rt = *(const u32x2*)pr_; g_kt = *(const u32x2*)(pr_ + 1024); g_vt = *(const u32x2*)(pr_ + 2048); \
        const bf16_t* pp_ = sg_ > 0 ? pr_ - 4096 : pr_; g_rp = *(const u32x2*)pp_; g_kp = *(const u32x2*)(pp_ + 1024); g_vp = *(const u32x2*)(pp_ + 2048); \
        g_et = *(const u32x2*)(E + (rowbase + sg_) * 1024 + c0); g_at = *(const u32x2*)(A + (rowbase + sg_) * 1024 + c0); } while (0)
#define SC_CVT(cn) do { const float pm_ = ((cn) * CH + ls) > 0 ? 1.f : 0.f; \
        f32x4 r_ = {bf_lo(g_rt.x), bf_hi(g_rt.x), bf_lo(g_rt.y), bf_hi(g_rt.y)}, k_ = {bf_lo(g_kt.x), bf_hi(g_kt.x), bf_lo(g_kt.y), bf_hi(g_kt.y)}, v_ = {bf_lo(g_vt.x), bf_hi(g_vt.x), bf_lo(g_vt.y), bf_hi(g_vt.y)}; \
        const f32x4 rq_ = (f32x4){bf_lo(g_rp.x), bf_hi(g_rp.x), bf_lo(g_rp.y), bf_hi(g_rp.y)} * pm_, kq_ = (f32x4){bf_lo(g_kp.x), bf_hi(g_kp.x), bf_lo(g_kp.y), bf_hi(g_kp.y)} * pm_, vq_ = (f32x4){bf_lo(g_vp.x), bf_hi(g_vp.x), bf_lo(g_vp.y), bf_hi(g_vp.y)} * pm_; \
        const f32x4 e_ = {h_lo(g_et.x), h_hi(g_et.x), h_lo(g_et.y), h_hi(g_et.y)}, a_ = {h_lo(g_at.x), h_hi(g_at.x), h_lo(g_at.y), h_hi(g_at.y)}; \
        r_ += mr * (rq_ - r_); k_ += mk * (kq_ - k_); v_ += mv * (vq_ - v_); \
        const f32x4 kkv_ = k_ * kkp; float ss_ = (kkv_[0] * kkv_[0] + kkv_[1] * kkv_[1]) + (kkv_[2] * kkv_[2] + kkv_[3] * kkv_[3]); ss_ = allred16(ss_); \
        const float inv_ = __builtin_amdgcn_rsqf(fmaxf(ss_, 1e-24f)); const f32x4 kk_ = kkv_ * inv_;     \
        float* st_ = (float*)(lds + ((cn) & 1) * BUFB + ls * STEPB) + lq * 4; \
        *(f32x4*)(st_) = -kk_; \
        *(f32x4*)(st_ + 64) = (f32x4){__expf(-e_[0]), __expf(-e_[1]), __expf(-e_[2]), __expf(-e_[3])}; \
        *(f32x4*)(st_ + 128) = kk_ * a_; \
        const f32x4 kf_ = k_ * ((a_ - 1.f) * kap + 1.f); *(f32x4*)(st_ + 192) = kf_; \
        if (half == 0) { const f32x4 bq_ = r_ * kf_ * rkp; float bn_ = allred16((bq_[0] + bq_[1]) + (bq_[2] + bq_[3])); if (lq == 0) BON[(rowbase + (size_t)(cn) * CH + ls) * 16 + h] = bn_; } \
        *(f32x4*)(st_ + 256) = r_; \
        if (myv) *(f32x4*)((float*)(lds + ((cn) & 1) * BUFB + ls * STEPB) + 320 + (lq & 7) * 4) = v_; } while (0)
#define SC_YOUT(cn) do { if (lq < 8) { const f32x4 y_ = *(const f32x4*)((const float*)(lds + OFF_Y + ((cn) & 1) * YB) + ls * 32 + lq * 4); \
        u32x2 o_; o_.x = cvtpk(y_[0], y_[1]); o_.y = cvtpk(y_[2], y_[3]); \
        *(u32x2*)(Y + (rowbase + (size_t)(cn) * CH + ls) * 1024 + h * 64 + half * 32 + lq * 4) = o_; } } while (0)
    const int cgp = lane & 15, row = wid * 4 + (lane >> 4);
    f32x4 S = {0.f, 0.f, 0.f, 0.f};
    SC_LOAD(0); SC_CVT(0);
    __syncthreads();
    for (int c = 0; c < NCH; ++c) {
        if (c > 0) SC_YOUT(c - 1);
        if (c + 1 < NCH) SC_LOAD(c + 1);
        const float* base = (const float*)(lds + (c & 1) * BUFB) + cgp * 4;
        const float* vbp = (const float*)(lds + (c & 1) * BUFB) + 320 + row;
        float* yb = (float*)(lds + OFF_Y + (c & 1) * YB) + row;
        float* ybw = cgp == 0 ? yb : (float*)(lds + OFF_YD) + wid * 64 + lane; const int ybs = cgp == 0 ? 32 : 0;
        f32x4 a4 = *(const f32x4*)(base), w4 = *(const f32x4*)(base + 64), b4 = *(const f32x4*)(base + 128), k4 = *(const f32x4*)(base + 192), r4 = *(const f32x4*)(base + 256);
        float v1 = *vbp; float ypart = 0.f;
#pragma unroll 4
        for (int s = 0; s < CH; ++s) {
            const int sn = s + 1;
            const float* st = base + sn * STEP_F;
            const f32x4 na4 = *(const f32x4*)(st), nw4 = *(const f32x4*)(st + 64), nb4 = *(const f32x4*)(st + 128), nk4 = *(const f32x4*)(st + 192), nr4 = *(const f32x4*)(st + 256);
            const float nv1 = vbp[sn * STEP_F];
            float p = (S[0] * a4[0] + S[1] * a4[1]) + (S[2] * a4[2] + S[3] * a4[3]);
            p = dpp_add<0xB1>(p); ypart = dpp_add<0xB1>(ypart); p = dpp_add<0x4E>(p); ypart = dpp_add<0x4E>(ypart);
            p = dpp_add<0x141>(p); ypart = dpp_add<0x141>(ypart); p = dpp_add<0x140>(p); ypart = dpp_add<0x140>(ypart);
            if (s > 0) ybw[(s - 1) * ybs] = ypart;
            S = S * w4 + (b4 * p + k4 * v1);
            ypart = (S[0] * r4[0] + S[1] * r4[1]) + (S[2] * r4[2] + S[3] * r4[3]);
            a4 = na4; w4 = nw4; b4 = nb4; k4 = nk4; r4 = nr4; v1 = nv1;
        }
        ypart = allred16(ypart);
        ybw[(CH - 1) * ybs] = ypart;
        if (c + 1 < NCH) SC_CVT(c + 1);
        __syncthreads();
    }
    SC_YOUT(NCH - 1);
    __syncthreads();
#undef SC_LOAD
#undef SC_CVT
#undef SC_YOUT
}
}

__device__ __forceinline__ void post_phase(unsigned char* ws, const float* mu, const float* ln_g, const float* ln_b, int gt, int ngt) {
    const bf16_t* PR = (const bf16_t*)(ws + WS_PR); bf16_t* Y = (bf16_t*)(ws + WS_BUFA); const float* BON = (const float*)(ws + WS_SSQ);
    const int g = gt & 127, c0 = g * 8;
    const f32x4 mv0 = *(const f32x4*)(mu + 2048 + c0), mv1 = *(const f32x4*)(mu + 2048 + c0 + 4), mg0 = *(const f32x4*)(mu + 3072 + c0), mg1 = *(const f32x4*)(mu + 3072 + c0 + 4);
    const f32x4 lg0 = *(const f32x4*)(ln_g + c0), lg1 = *(const f32x4*)(ln_g + c0 + 4), lb0 = *(const f32x4*)(ln_b + c0), lb1 = *(const f32x4*)(ln_b + c0 + 4);
    u32x4 n_vt, n_gt, n_vp, n_gp, n_yt; float n_bon;
#define POST_LOAD(ix) do { const int t_ = (ix) >> 7; const bf16_t* pr_ = PR + (size_t)t_ * 4096 + c0; const int pv_ = (t_ & (SEQ - 1)) > 0 ? 4096 : 0; \
        n_vt = *(const u32x4*)(pr_ + 2048); n_gt = *(const u32x4*)(pr_ + 3072); n_vp = *(const u32x4*)(pr_ - pv_ + 2048); n_gp = *(const u32x4*)(pr_ - pv_ + 3072); \
        n_yt = *(const u32x4*)(Y + (size_t)t_ * 1024 + c0); n_bon = BON[(size_t)t_ * 16 + (g >> 3)]; } while (0)
    if (gt < T * 128) POST_LOAD(gt);
    for (int idx = gt; idx < T * 128; idx += ngt) {
        const int t = idx >> 7; const int s = t & (SEQ - 1);
        const u32x4 vt = n_vt, gt_ = n_gt, yt = n_yt; u32x4 vp = n_vp, gp = n_gp; const float bon = n_bon;
        if (s == 0) { vp = (u32x4){0u, 0u, 0u, 0u}; gp = vp; }
        { const int nx = idx + ngt < T * 128 ? idx + ngt : idx; POST_LOAD(nx); }
        float v_[8], g_[8], vq[8], gq[8], y_[8];
        unpack8bf(vt, v_); unpack8bf(gt_, g_); unpack8bf(vp, vq); unpack8bf(gp, gq); unpack8bf(yt, y_);
        float ysum = 0.f;
#pragma unroll
        for (int e = 0; e < 8; ++e) { const float mve = e < 4 ? mv0[e & 3] : mv1[e & 3], mge = e < 4 ? mg0[e & 3] : mg1[e & 3];
            v_[e] += mve * (vq[e] - v_[e]); g_[e] += mge * (gq[e] - g_[e]); ysum += y_[e]; }
        ysum += __shfl_xor(ysum, 1); ysum += __shfl_xor(ysum, 2); ysum += __shfl_xor(ysum, 4);
        const float mean = ysum * (1.f / 64.f); float var = 0.f;
#pragma unroll
        for (int e = 0; e < 8; ++e) { const float d = y_[e] - mean; var += d * d; }
        var += __shfl_xor(var, 1); var += __shfl_xor(var, 2); var += __shfl_xor(var, 4);
        const float rstd = 1.0f / sqrtf(var * (1.f / 64.f) + GN_EPS);
        f32x4 o0, o1;
#pragma unroll
        for (int e = 0; e < 8; ++e) { const float lge = e < 4 ? lg0[e & 3] : lg1[e & 3], lbe = e < 4 ? lb0[e & 3] : lb1[e & 3];
            const float yn = (y_[e] - mean) * rstd * lge + lbe + bon * v_[e];
            const float ov = yn * siluf_(g_[e]);
            if (e < 4) o0[e] = ov; else o1[e - 4] = ov; }
        *(u32x4*)(Y + (size_t)t * 1024 + c0) = pack8bf(o0, o1);
    }
#undef POST_LOAD
}

#define LAS __attribute__((address_space(3)))
#define XB_TMO      128
#define XB_XCNT(j)  (256  + 64 * (j))
#define XB_XSUB(j)  (1280 + 64 * (j))
#define XB_XGEN(j)  (2304 + 64 * (j))
#define XB_TOP      3328
#define XB_TOPGEN   3392
#define XCD_BAR_WORDS 3456
#define XB_SPIN_CAP (1u << 18)

__device__ __forceinline__ unsigned xb_ld(unsigned* p)              { return __hip_atomic_load(p, __ATOMIC_RELAXED, __HIP_MEMORY_SCOPE_AGENT); }
__device__ __forceinline__ unsigned xb_add(unsigned* p, unsigned v) { return __hip_atomic_fetch_add(p, v, __ATOMIC_RELAXED, __HIP_MEMORY_SCOPE_AGENT); }
__device__ __forceinline__ unsigned xb_xcc_id() { return (unsigned)__builtin_amdgcn_s_getreg((3 << 11) | 20) & 0xFu; }
#define XB_SPIN(cond, bar) do { unsigned _sp = 0; while (cond) { __builtin_amdgcn_s_sleep(1); \
    if ((++_sp & 255u) == 0u) { if (xb_ld(&(bar)[XB_TMO])) break; if (_sp > XB_SPIN_CAP) { atomicAdd(&(bar)[XB_TMO], 1u); break; } } } } while (0)

struct XcdBarrier {
    unsigned* bar; unsigned x;
    volatile LAS unsigned* st;
};

__device__ __forceinline__ XcdBarrier xcd_barrier_post(unsigned* bar, volatile LAS unsigned* st) {
    XcdBarrier b; b.bar = bar; b.x = xb_xcc_id(); b.st = st;
    if (threadIdx.x == 0) (void)xb_add(&bar[XB_XCNT(b.x)], 1u);
    return b;
}
__device__ __forceinline__ void xcd_barrier_complete(unsigned* bar, unsigned x, unsigned& nloc, unsigned& nx) {
    const unsigned G = gridDim.x * gridDim.y * gridDim.z;
    unsigned sum, cnt, mine, sp = 0u;
    for (;;) {
        sum = 0u; cnt = 0u; mine = 0u;
#pragma unroll
        for (unsigned j = 0; j < 16; ++j) { const unsigned c = xb_ld(&bar[XB_XCNT(j)]); sum += c; cnt += (c > 0u) ? 1u : 0u; mine = (j == x) ? c : mine; }
        if (sum == G) break;
        __builtin_amdgcn_s_sleep(1);
        if ((++sp & 255u) == 0u) { if (xb_ld(&bar[XB_TMO])) break; if (sp > XB_SPIN_CAP) { atomicAdd(&bar[XB_TMO], 1u); break; } }
    }
    nloc = mine > 0u ? mine : 1u; nx = cnt > 0u ? cnt : 1u;
}

__device__ __forceinline__ void xcd_barrier(const XcdBarrier& b) {
    asm volatile("s_waitcnt vmcnt(0)" ::: "memory");
    __syncthreads();
    if (threadIdx.x == 0) {
        unsigned* bar = b.bar;
        __builtin_amdgcn_s_waitcnt(0);
        unsigned nloc = b.st[0], nx = b.st[1];
        if (nloc == 0u) { xcd_barrier_complete(bar, b.x, nloc, nx); b.st[0] = nloc; b.st[1] = nx; }
        const unsigned old = xb_add(&bar[XB_XSUB(b.x)], 1u);
        const unsigned gen = old / nloc;
        if (old + 1u == (gen + 1u) * nloc) {
            __builtin_amdgcn_fence(__ATOMIC_RELEASE, "agent");
            asm volatile("s_waitcnt vmcnt(0)" ::: "memory");
            const unsigned og = xb_add(&bar[XB_TOP], 1u);
            const unsigned tg = og / nx;
            if (og + 1u == (tg + 1u) * nx) xb_add(&bar[XB_TOPGEN], 1u);
            else XB_SPIN(xb_ld(&bar[XB_TOPGEN]) == tg, bar);
            __builtin_amdgcn_fence(__ATOMIC_ACQUIRE, "agent");
            xb_add(&bar[XB_XGEN(b.x)], 1u);
            asm volatile("s_waitcnt vmcnt(0)" ::: "memory");
        } else {
            XB_SPIN(xb_ld(&bar[XB_XGEN(b.x)]) == gen, bar);
            __builtin_amdgcn_fence(__ATOMIC_ACQUIRE, "agent");
            asm volatile("s_waitcnt vmcnt(0)" ::: "memory");
        }
    }
    __syncthreads();
}

__global__ void __launch_bounds__(NTHREADS, 2) fwd_megakernel(Args a) {
    extern __shared__ __attribute__((aligned(16))) unsigned char lds[];
    cg::grid_group grid = cg::this_grid();
    const int ph_hi = a.ph_hi < 22 ? a.ph_hi : 22;
    if (threadIdx.x < 64) ((LAS unsigned*)(lds + LDS_MISC))[threadIdx.x] = 0u;
    __syncthreads();
    { typedef const __attribute__((address_space(4))) Args* ArgsP0; ArgsP0 ap0 = (ArgsP0)__builtin_amdgcn_kernarg_segment_ptr();
      (void)xcd_barrier_post((unsigned*)(ap0->ws + WS_BAR), (volatile LAS unsigned*)(lds + LDS_MISC)); }
#pragma nounroll
    for (int p = a.ph_lo; p < ph_hi; ++p) {
        typedef const __attribute__((address_space(4))) Args* ArgsP;
        ArgsP ap = (ArgsP)__builtin_amdgcn_kernarg_segment_ptr(); asm volatile("" : "+s"(ap));
        int pp = p; asm volatile("" : "+s"(pp));
        int G0_ = gridDim.x, bx0_ = blockIdx.x; asm volatile("" : "+s"(G0_), "+s"(bx0_));
        const int G_ = G0_, bx = bx0_;
        const int vcu = (G_ % 8 == 0) ? (bx % 8) * (G_ / 8) + bx / 8 : bx;
#define TIDS() int tid_ = threadIdx.x; asm volatile("" : "+v"(tid_)); const int lane = tid_ & 63, wave = __builtin_amdgcn_readfirstlane(tid_ >> 6); \
        const int gw = vcu * 8 + wave, ngw = G_ * 8, gt = gw * 64 + lane, ngt = ngw * 64; (void)gt; (void)ngt; (void)gw; (void)ngw
        unsigned char* ws = ap->ws;
        PG8_LAS unsigned char* lds3 = (PG8_LAS unsigned char*)lds;
        const int q_ = pp - 1, jj = q_ / 10, r = q_ - jj * 10;
        const int rr_ = pp == 0 ? 10 : (pp == 21 ? 11 : r);
        bf16_t* XB = (bf16_t*)ap->out;
        switch (rr_) {
        case 11: { TIDS(); final_norm((const float*)(ws + WS_XF), ap->out, (const float*)ap->in[21], gw, ngw, lane); } break;
        case 10: { TIDS();
            prep_weights(ap, lds, wave, lane, gw, ngw);
            conv_rows_bf16((const float*)ap->in[0], XB, (float*)(ws + WS_SSX), gw, ngw, lane);
        } break;
        case 0: {
            int K_ = 1024; asm volatile("" : "+s"(K_)); pg8::Gemm g{XB, (const bf16_t*)(ws + WS_W + (size_t)jj * SZ_MLA), T, 2304, K_}; pg8::StaticOrder S; S.init(T, 2304, G_, bx);
            pg8::EpiMlaIn E{ws, (const int*)ap->in[1]};
            pg8::gemm_phase<pg8::EpiMlaIn, pg8::StaticOrder, true, true>(lds3, g, S, E);
        } break;
        case 1: {
            { int K_ = 768; asm volatile("" : "+s"(K_)); pg8::Gemm g{(const bf16_t*)(ws + WS_QLAT), (const bf16_t*)(ws + WS_W + (size_t)jj * SZ_MLA + SZ_MWIN), T, 1536, K_}; pg8::StaticOrder S; S.init(T, 1536, G_, bx);
              pg8::EpiUq E{ws, (const int*)ap->in[1]};
              pg8::gemm_phase<pg8::EpiUq, pg8::StaticOrder, true, true>(lds3, g, S, E); }
            { int K_ = 256; asm volatile("" : "+s"(K_)); pg8::Gemm g{(const bf16_t*)(ws + WS_KVLAT), (const bf16_t*)(ws + WS_W + (size_t)jj * SZ_MLA + SZ_MWIN + SZ_MWUQ), T, 2048, K_}; pg8::StaticOrder S; S.init(T, 2048, G_, bx);
              pg8::EpiUkv E{ws};
              pg8::gemm_phase<pg8::EpiUkv, pg8::StaticOrder, true, true>(lds3, g, S, E); }
        } break;
        case 2: { att::attn_phase(ws, (char*)lds, vcu, G_); } break;
        case 3: case 9: {
            const size_t woff = r == 3 ? WS_W + (size_t)jj * SZ_MLA + SZ_MWIN + SZ_MWUQ + SZ_MWUKV : WS_W + 2 * SZ_MLA + (size_t)jj * SZ_RWKV + SZ_RWIN + SZ_RWL;
            int K_ = 1024; asm volatile("" : "+s"(K_)); pg8::Gemm g{(const bf16_t*)(ws + WS_BUFA), (const bf16_t*)(ws + woff), T, 1024, K_}; pg8::StaticOrder S; S.init(T, 1024, G_, bx);
            pg8::EpiResid E{XB, (float*)(ws + WS_SSX), pp == 20 ? (float*)(ws + WS_XF) : (float*)nullptr};
            pg8::gemm_phase<pg8::EpiResid, pg8::StaticOrder, true, true>(lds3, g, S, E);
        } break;
        case 4: {
            int K_ = 1024; asm volatile("" : "+s"(K_)); pg8::Gemm g{XB, (const bf16_t*)(ws + WS_W + 2 * SZ_MLA + (size_t)jj * SZ_RWKV), T, 4352, K_}; pg8::StaticOrder S; S.init(T, 4352, G_, bx);
            pg8::EpiRwkvIn E{ws};
            pg8::gemm_phase<pg8::EpiRwkvIn, pg8::StaticOrder, true, true>(lds3, g, S, E);
        } break;
        case 5: { TIDS(); lora_in_phase((const float*)(ws + WS_LARAW), (const float*)ap->in[10] + jj * 4224, (bf16_t*)(ws + WS_LA), gt, ngt); } break;
        case 6: {
            int K_ = 128; asm volatile("" : "+s"(K_)); pg8::Gemm g{(const bf16_t*)(ws + WS_LA), (const bf16_t*)(ws + WS_W + 2 * SZ_MLA + (size_t)jj * SZ_RWKV + SZ_RWIN), T, 2048, K_}; pg8::StaticOrder S; S.init(T, 2048, G_, bx);
            pg8::EpiLora E{ws, (const float*)ap->in[11] + jj * 1024, (const float*)ap->in[13] + jj * 1024};
            pg8::gemm_phase<pg8::EpiLora, pg8::StaticOrder, true, true>(lds3, g, S, E);
        } break;
        case 7: {
            for (int item = vcu; item < 256; item += G_)
                scan::scan_item(item, ws, (const float*)ap->in[10] + jj * 4224, (const float*)ap->in[15] + jj * 1024, (const float*)ap->in[16] + jj * 1024, (const float*)ap->in[17] + jj * 1024, (char*)lds);
        } break;
        default: { TIDS();
            post_phase(ws, (const float*)ap->in[10] + jj * 4224, (const float*)ap->in[18] + jj * 1024, (const float*)ap->in[19] + jj * 1024, gt, ngt);
        } break;
        }
        if (p + 1 < ph_hi) {
            if (p == a.ph_lo) grid.sync();
            else { XcdBarrier xb; xb.bar = (unsigned*)(ws + WS_BAR); xb.x = xb_xcc_id(); xb.st = (volatile LAS unsigned*)(lds + LDS_MISC); xcd_barrier(xb); }
        }
    }
}

extern "C" void kernel_launch(void* const* d_in, const int* in_sizes, int n_in, void* d_out, int out_size, void* d_ws, size_t ws_size, hipStream_t stream) {
    static int grid = 0;
    if (grid == 0) {
        if (n_in != 22 || in_sizes[0] != T * DM || out_size != T * DM || ws_size < WS_END) {
            fprintf(stderr, "kernel_launch: unexpected shapes (n_in %d, in0 %d, out %d, ws %zu, need %zu); nothing launched\n", n_in, n_in > 0 ? in_sizes[0] : -1, out_size, ws_size, (size_t)WS_END);
            grid = -1; return; }
        int dev = 0, cus = 0, per_cu = 0;
        (void)hipGetDevice(&dev);
        (void)hipDeviceGetAttribute(&cus, hipDeviceAttributeMultiprocessorCount, dev);
        if (hipFuncSetAttribute((const void*)fwd_megakernel, hipFuncAttributeMaxDynamicSharedMemorySize, LDS_BYTES) != hipSuccess) fprintf(stderr, "kernel_launch: hipFuncSetAttribute failed\n");
        if (hipOccupancyMaxActiveBlocksPerMultiprocessor(&per_cu, (const void*)fwd_megakernel, NTHREADS, LDS_BYTES) != hipSuccess || per_cu < 1) { fprintf(stderr, "kernel_launch: occupancy query gave %d\n", per_cu); per_cu = 1; }
        (void)hipGetLastError();
        if (cus <= 0) cus = 256;
        grid = cus * per_cu;
        fprintf(stderr, "kernel_launch: grid %d (cus %d x %d)\n", grid, cus, per_cu);
    }
    if (grid < 0) return;
    if (hipMemsetAsync((char*)d_ws + WS_BAR, 0, BAR_BYTES, stream) != hipSuccess) { fprintf(stderr, "kernel_launch: memset failed\n"); return; }
    Args a{};
    for (int i = 0; i < 22; ++i) a.in[i] = d_in[i];
    a.out = (float*)d_out; a.ws = (unsigned char*)d_ws;
#if defined(MK_MULTI)
    for (int p = 0; p < 22; ++p) { a.ph_lo = p; a.ph_hi = p + 1; hipLaunchKernelGGL(fwd_megakernel, dim3(grid), dim3(NTHREADS), LDS_BYTES, stream, a); }
#else
    a.ph_lo = 0; a.ph_hi = 1000;
    void* args[] = {&a};
    hipError_t e = hipLaunchCooperativeKernel((const void*)fwd_megakernel, dim3(grid), dim3(NTHREADS), args, LDS_BYTES, stream);
    if (e != hipSuccess) fprintf(stderr, "kernel_launch: cooperative launch failed: %s (grid %d)\n", hipGetErrorString(e), grid);
#endif
}
```

```cpp
#include <hip/hip_runtime.h>
#include <hip/hip_cooperative_groups.h>
#include <cstdio>
#include <cstdint>
#include <cmath>
namespace cg = cooperative_groups;
namespace pg8 {
#define PG8_LAS __attribute__((address_space(3)))
typedef unsigned short bf16_t;
typedef short bf16x8 __attribute__((ext_vector_type(8)));
typedef float f32x4 __attribute__((ext_vector_type(4)));
typedef unsigned u32x4 __attribute__((ext_vector_type(4)));
constexpr int BM = 256, BK = 64, HALF = 128, HTB = HALF * BK * 2  , STAGE_BYTES = 8 * HTB, NXCD = 8, WGM = 8;

__host__ __device__ __forceinline__ int lds_byte(int r, int c) { const int st = (r >> 4) * 2 + (c >> 5), rr = r & 15, cc = c & 31, ob = rr * 64 + cc * 2; return st * 1024 + (ob ^ (((ob >> 9) & 1) << 5)); }
__host__ __device__ __forceinline__ void stage_rc(int b, int& R, int& C) { const int st = b / 1024, sb = b % 1024, swz = sb ^ (((sb >> 9) & 1) << 5); R = (st >> 1) * 16 + swz / 64; C = (st & 1) * 32 + (swz % 64) / 2; }
__host__ __device__ __forceinline__ int perm32(int rho) { const int n = rho >> 4, i = rho & 15; return 8 * (i >> 2) + 4 * n + (i & 3); }

struct Unit { int pm, pn; };
struct Gemm { const bf16_t* A; const bf16_t* Bt; int M, N, K; };

struct StaticOrder {
    int nM, nN, nwg, G, c;
    __host__ __device__ void init(int M, int N, int G_, int c_) { nM = M / BM; nN = N / BM; nwg = nM * nN; G = G_; c = c_; }
    __host__ __device__ bool next(int i, Unit& u) const {
        const long L = (long)i * G + c; if (L >= nwg) return false;
        int wgid = (int)L; { const int q = nwg / NXCD, r = nwg % NXCD, xcd = wgid % NXCD, off = wgid / NXCD; wgid = (xcd < r ? xcd * (q + 1) : r * (q + 1) + (xcd - r) * q) + off; }
        const int nig = WGM * nN, gid = wgid / nig, fm = gid * WGM, gsz = (nM - fm) < WGM ? (nM - fm) : WGM;
        u.pm = fm + ((wgid % nig) % gsz); u.pn = (wgid % nig) / gsz; return true;
    }
    __device__ __forceinline__ void a_ready(const Unit&) const {}
    __device__ __forceinline__ void done(const Unit&) const {}
};

__device__ __forceinline__ unsigned cvt_pk_bf16(float lo, float hi) { unsigned r; asm volatile("v_cvt_pk_bf16_f32 %0, %1, %2" : "=v"(r) : "v"(lo), "v"(hi)); return r; }
typedef float f32x2 __attribute__((ext_vector_type(2)));
template <class Epi, class Sched, bool ALIGN_EPI = false, bool SP2 = false>
__device__ __forceinline__ void gemm_phase(PG8_LAS unsigned char* lds, const Gemm g, const Sched& S, const Epi& E) {
    int tid_ = threadIdx.x; asm volatile("" : "+v"(tid_));
    const int tid = tid_, wid = __builtin_amdgcn_readfirstlane(tid >> 6), lane = tid & 63, wr = wid >> 2, wc = wid & 3, fr = lane & 15, fq = lane >> 4;
    const int K = g.K, nt = K / BK;
    unsigned voffA[2], voffB[2];
#pragma unroll
    for (int i = 0; i < 2; ++i) { int R, C; stage_rc(tid * 16 + i * 8192, R, C); const int Rb = Epi::PERM ? ((R & ~31) + perm32(R & 31)) : R;
        voffA[i] = (unsigned)(R * K + C) * 2u; voffB[i] = (unsigned)(Rb * K + C) * 2u; }
    const size_t kstep = (size_t)(BK * 2);
    const size_t hstep = (size_t)HALF * K * 2;
    const size_t tstep = 2 * hstep;
    const unsigned ldsw = (unsigned)wid * 1024u;
    const int aoff = lds_byte(wr * 64 + fr, fq * 8), boff = lds_byte(wc * 32 + fr, fq * 8);
#define PG8_SA(b, h) (((b) * 2 + (h)) * HTB)
#define PG8_SB(b, h) ((4 + (b) * 2 + (h)) * HTB)
#define PG8_STAGE(bufoff, gbase, voff) do { _Pragma("unroll") for (int _i = 0; _i < 2; ++_i) \
        __builtin_amdgcn_global_load_lds((const unsigned*)((const char*)(gbase) + (voff)[_i]), (PG8_LAS unsigned*)(lds + (bufoff) + ldsw + _i * 8192), 16, 0, 0); } while (0)
#define PG8_LDA(dst, b, h) do { _Pragma("unroll") for (int m = 0; m < 4; ++m) _Pragma("unroll") for (int k = 0; k < 2; ++k) dst[m][k] = *(const PG8_LAS bf16x8*)(lds + PG8_SA(b, h) + aoff + m * 2048 + k * 1024); } while (0)
#define PG8_LDB(dst, b, h) do { _Pragma("unroll") for (int n = 0; n < 2; ++n) _Pragma("unroll") for (int k = 0; k < 2; ++k) dst[n][k] = *(const PG8_LAS bf16x8*)(lds + PG8_SB(b, h) + boff + n * 2048 + k * 1024); } while (0)
#define PG8_MMA(ai, bj, At, Bt) do { __builtin_amdgcn_s_setprio(1); _Pragma("unroll") for (int m = 0; m < 4; ++m) _Pragma("unroll") for (int n = 0; n < 2; ++n) _Pragma("unroll") for (int k = 0; k < 2; ++k) \
        acc[ai][bj][m][n] = __builtin_amdgcn_mfma_f32_16x16x32_bf16(Bt[n][k], At[m][k], acc[ai][bj][m][n], 0, 0, 0); __builtin_amdgcn_s_setprio(0); } while (0)
#define PG8_WAIT_V(n) asm volatile("s_waitcnt vmcnt(" #n ")" ::: "memory")
#define PG8_WAIT_L(n) asm volatile("s_waitcnt lgkmcnt(" #n ")" ::: "memory")
#define PG8_BAR __builtin_amdgcn_s_barrier()
#define PG8_SCHED __builtin_amdgcn_sched_barrier(0)
    Unit cur, nxt; int ui = 0;
    if (!S.next(0, cur)) return;
    f32x4 acc[2][2][4][2];
#pragma unroll
    for (int a = 0; a < 2; ++a)
#pragma unroll
        for (int b = 0; b < 2; ++b)
#pragma unroll
            for (int m = 0; m < 4; ++m)
#pragma unroll
                for (int n = 0; n < 2; ++n) acc[a][b][m][n] = (f32x4){0.f, 0.f, 0.f, 0.f};
    bf16x8 At[4][2], B0[2][2], B1[2][2];
    const char* cA = (const char*)g.A + (size_t)cur.pm * tstep; const char* cB = (const char*)g.Bt + (size_t)cur.pn * tstep;
    S.a_ready(cur);
    if constexpr (SP2) {
        PG8_STAGE(PG8_SB(0, 0), cB, voffB); PG8_STAGE(PG8_SB(0, 1), cB + hstep, voffB); PG8_STAGE(PG8_SA(0, 0), cA, voffA); PG8_STAGE(PG8_SA(0, 1), cA + hstep, voffA);
        if (wr == 1) PG8_BAR;
        PG8_WAIT_V(2); PG8_BAR;
        PG8_STAGE(PG8_SB(1, 0), cB + kstep, voffB); PG8_STAGE(PG8_SA(1, 0), cA + kstep, voffA); PG8_STAGE(PG8_SB(1, 1), cB + hstep + kstep, voffB);
        PG8_WAIT_V(6); PG8_BAR;
    } else {
        PG8_STAGE(PG8_SB(0, 0), cB, voffB); PG8_STAGE(PG8_SA(0, 0), cA, voffA); PG8_STAGE(PG8_SB(0, 1), cB + hstep, voffB); PG8_STAGE(PG8_SA(0, 1), cA + hstep, voffA);
        if (wr == 1) PG8_BAR;
        PG8_WAIT_V(4); PG8_BAR;
        PG8_STAGE(PG8_SB(1, 0), cB + kstep, voffB); PG8_STAGE(PG8_SA(1, 0), cA + kstep, voffA); PG8_STAGE(PG8_SB(1, 1), cB + hstep + kstep, voffB);
        PG8_WAIT_V(6); PG8_BAR;
    }
    for (;;) {
        const bool has_next = S.next(ui + 1, nxt);
        const char* nA = has_next ? (const char*)g.A + (size_t)nxt.pm * tstep : cA; const char* nB = has_next ? (const char*)g.Bt + (size_t)nxt.pn * tstep : cB;
        for (int t = 0; t < nt; t += 2) {
            const bool last = (t == nt - 2);
            const char* a1 = cA + (size_t)(t + 1) * kstep;
            const char* a2 = last ? nA : cA + (size_t)(t + 2) * kstep; const char* b2 = last ? nB : cB + (size_t)(t + 2) * kstep;
            const char* a3 = a2 + kstep; const char* b3 = b2 + kstep;
            if (last && has_next) S.a_ready(nxt);
            if constexpr (SP2) {
            PG8_LDB(B0, 0, 0); PG8_LDB(B1, 0, 1); PG8_SCHED; PG8_LDA(At, 0, 0); PG8_STAGE(PG8_SA(1, 1), a1 + hstep, voffA);
            PG8_WAIT_V(8); PG8_WAIT_L(0); PG8_BAR; PG8_MMA(0, 0, At, B0); PG8_MMA(0, 1, At, B1); PG8_BAR; PG8_SCHED;
            PG8_LDA(At, 0, 1); PG8_STAGE(PG8_SB(0, 0), b2, voffB); PG8_STAGE(PG8_SB(0, 1), b2 + hstep, voffB); PG8_STAGE(PG8_SA(0, 0), a2, voffA);
            PG8_WAIT_V(8); PG8_WAIT_L(0); PG8_BAR; PG8_MMA(1, 0, At, B0); PG8_MMA(1, 1, At, B1); PG8_BAR; PG8_SCHED;
            PG8_LDB(B0, 1, 0); PG8_LDB(B1, 1, 1); PG8_SCHED; PG8_LDA(At, 1, 0); PG8_STAGE(PG8_SA(0, 1), a2 + hstep, voffA);
            PG8_WAIT_V(8); PG8_WAIT_L(0); PG8_BAR; PG8_MMA(0, 0, At, B0); PG8_MMA(0, 1, At, B1); PG8_BAR; PG8_SCHED;
            PG8_LDA(At, 1, 1); PG8_STAGE(PG8_SB(1, 0), b3, voffB); PG8_STAGE(PG8_SB(1, 1), b3 + hstep, voffB); PG8_STAGE(PG8_SA(1, 0), a3, voffA);
            PG8_WAIT_V(8); PG8_WAIT_L(0); PG8_BAR; PG8_MMA(1, 0, At, B0); PG8_MMA(1, 1, At, B1); PG8_BAR; PG8_SCHED;
            } else {
            PG8_LDB(B0, 0, 0); PG8_SCHED; PG8_LDA(At, 0, 0); PG8_STAGE(PG8_SA(1, 1), a1 + hstep, voffA);
            PG8_WAIT_L(8); PG8_BAR; PG8_WAIT_L(0); PG8_MMA(0, 0, At, B0); PG8_BAR; PG8_SCHED;
            PG8_LDB(B1, 0, 1); PG8_STAGE(PG8_SB(0, 0), b2, voffB);
            PG8_BAR; PG8_WAIT_L(0); PG8_MMA(0, 1, At, B1); PG8_BAR;
            PG8_LDA(At, 0, 1); PG8_STAGE(PG8_SA(0, 0), a2, voffA);
            PG8_BAR; PG8_WAIT_L(0); PG8_MMA(1, 0, At, B0); PG8_BAR; PG8_SCHED;
            PG8_STAGE(PG8_SB(0, 1), b2 + hstep, voffB);
            PG8_WAIT_V(6); PG8_BAR; PG8_MMA(1, 1, At, B1); PG8_BAR;
            PG8_LDB(B0, 1, 0); PG8_SCHED; PG8_LDA(At, 1, 0); PG8_STAGE(PG8_SA(0, 1), a2 + hstep, voffA);
            PG8_WAIT_L(8); PG8_BAR; PG8_WAIT_L(0); PG8_MMA(0, 0, At, B0); PG8_BAR; PG8_SCHED;
            PG8_LDB(B1, 1, 1); PG8_STAGE(PG8_SB(1, 0), b3, voffB);
            PG8_BAR; PG8_WAIT_L(0); PG8_MMA(0, 1, At, B1); PG8_BAR;
            PG8_LDA(At, 1, 1); PG8_STAGE(PG8_SA(1, 0), a3, voffA);
            PG8_BAR; PG8_WAIT_L(0); PG8_MMA(1, 0, At, B0); PG8_BAR; PG8_SCHED;
            PG8_STAGE(PG8_SB(1, 1), b3 + hstep, voffB);
            PG8_WAIT_V(6); PG8_BAR; PG8_MMA(1, 1, At, B1); PG8_BAR;
            }
        }
        if constexpr (ALIGN_EPI) { if (wr == 0) PG8_BAR; }
        if constexpr (!Epi::AFTER_DRAIN) { E(acc, cur, wr, wc, fr, fq); S.done(cur); }
        if (!has_next) break;
#pragma unroll
        for (int a = 0; a < 2; ++a)
#pragma unroll
            for (int b = 0; b < 2; ++b)
#pragma unroll
                for (int m = 0; m < 4; ++m)
#pragma unroll
                    for (int n = 0; n < 2; ++n) acc[a][b][m][n] = (f32x4){0.f, 0.f, 0.f, 0.f};
        cur = nxt; cA = nA; cB = nB; ++ui;
        if constexpr (ALIGN_EPI) { if (wr == 1) PG8_BAR; }
    }
    PG8_WAIT_V(0);
    if constexpr (!ALIGN_EPI) { if (wr == 0) PG8_BAR; }
    PG8_BAR;
    if constexpr (Epi::AFTER_DRAIN) { E.fused(acc, cur, wr, wc, fr, fq, lds, wid, lane); S.done(cur); }
#undef PG8_SA
#undef PG8_SB
#undef PG8_STAGE
#undef PG8_LDA
#undef PG8_LDB
#undef PG8_MMA
#undef PG8_WAIT_V
#undef PG8_WAIT_L
#undef PG8_BAR
#undef PG8_SCHED
}
}

typedef pg8::bf16_t bf16_t;
typedef pg8::f32x4 f32x4;
typedef pg8::u32x4 u32x4;
typedef float f32x2 __attribute__((ext_vector_type(2)));
typedef float f32x16 __attribute__((ext_vector_type(16)));
typedef short bf16x8 __attribute__((ext_vector_type(8)));
typedef short s16x4 __attribute__((ext_vector_type(4)));
typedef _Float16 h16x2 __attribute__((ext_vector_type(2)));

constexpr int BATCH = 8, SEQ = 8192, DM = 1024, T = BATCH * SEQ;
constexpr float NORM_EPS = 1e-6f, GN_EPS = 64e-5f;
constexpr size_t MiB = 1u << 20;
constexpr size_t WS_SSQ = 44 * MiB;
constexpr size_t WS_W = 2 * MiB;
constexpr size_t SZ_MWIN = 2304u * 1024 * 2, SZ_MWUQ = 1536u * 768 * 2, SZ_MWUKV = 2048u * 256 * 2, SZ_WOUT = 1024u * 1024 * 2;
constexpr size_t SZ_MLA = SZ_MWIN + SZ_MWUQ + SZ_MWUKV + SZ_WOUT;
constexpr size_t SZ_RWIN = 4352u * 1024 * 2, SZ_RWL = 2048u * 128 * 2;
constexpr size_t SZ_RWKV = SZ_RWIN + SZ_RWL + SZ_WOUT;
static_assert(WS_W + 2 * SZ_MLA + 2 * SZ_RWKV <= 48 * MiB, "weights");
constexpr size_t WS_BUFA = 48 * MiB;
constexpr size_t WS_L = 176 * MiB;
constexpr size_t WS_QLAT = WS_L, WS_KVLAT = WS_L + 96 * MiB, WS_KROPE = WS_L + 128 * MiB, WS_GATE = WS_L + 136 * MiB, WS_Q = WS_L + 264 * MiB,
                 WS_KN = WS_L + 456 * MiB, WS_V = WS_L + 584 * MiB;
constexpr size_t WS_PR = WS_L, WS_LARAW = WS_L + 512 * MiB, WS_LA = WS_L + 544 * MiB, WS_E = WS_L + 560 * MiB, WS_A = WS_L + 688 * MiB;
constexpr size_t WS_SSX = WS_L + 816 * MiB;
constexpr size_t WS_END = WS_SSX + 4 * MiB;
constexpr size_t WS_XF = WS_PR;

constexpr int LDS_BYTES = 131072 + 1024;
constexpr int LDS_MISC = 131072;
constexpr size_t WS_BAR = 0, BAR_BYTES = 16384;
constexpr int NTHREADS = 512;

__device__ const float ROPE_INVF[32] = {
    1.000000000e+00f, 7.498942018e-01f, 5.623413324e-01f, 4.216965139e-01f, 3.162277639e-01f, 2.371373922e-01f, 1.778279394e-01f, 1.333521456e-01f,
    1.000000015e-01f, 7.498941571e-02f, 5.623412877e-02f, 4.216964915e-02f, 3.162277862e-02f, 2.371373586e-02f, 1.778279431e-02f, 1.333521493e-02f,
    9.999999776e-03f, 7.498942316e-03f, 5.623413250e-03f, 4.216964822e-03f, 3.162277862e-03f, 2.371373819e-03f, 1.778279431e-03f, 1.333521446e-03f,
    1.000000047e-03f, 7.498941850e-04f, 5.623413017e-04f, 4.216965463e-04f, 3.162277862e-04f, 2.371373848e-04f, 1.778279402e-04f, 1.333521504e-04f};

__device__ __forceinline__ unsigned cvtpk(float lo, float hi) { return pg8::cvt_pk_bf16(lo, hi); }
__device__ __forceinline__ u32x4 pack8bf(f32x4 a, f32x4 b) { u32x4 w; w.x = cvtpk(a[0], a[1]); w.y = cvtpk(a[2], a[3]); w.z = cvtpk(b[0], b[1]); w.w = cvtpk(b[2], b[3]); return w; }
__device__ __forceinline__ unsigned pkh(float lo, float hi) { h16x2 v = {(_Float16)lo, (_Float16)hi}; return __builtin_bit_cast(unsigned, v); }
__device__ __forceinline__ u32x4 pack8h(f32x4 a, f32x4 b) { u32x4 w; w.x = pkh(a[0], a[1]); w.y = pkh(a[2], a[3]); w.z = pkh(b[0], b[1]); w.w = pkh(b[2], b[3]); return w; }
__device__ __forceinline__ float bf_lo(unsigned w) { return __uint_as_float(w << 16); }
__device__ __forceinline__ float bf_hi(unsigned w) { return __uint_as_float(w & 0xffff0000u); }
__device__ __forceinline__ void unpack8bf(u32x4 w, float* f) { f[0] = bf_lo(w.x); f[1] = bf_hi(w.x); f[2] = bf_lo(w.y); f[3] = bf_hi(w.y); f[4] = bf_lo(w.z); f[5] = bf_hi(w.z); f[6] = bf_lo(w.w); f[7] = bf_hi(w.w); }
__device__ __forceinline__ float h_lo(unsigned w) { return (float)__builtin_bit_cast(_Float16, (unsigned short)(w & 0xffffu)); }
__device__ __forceinline__ float h_hi(unsigned w) { return (float)__builtin_bit_cast(_Float16, (unsigned short)(w >> 16)); }
__device__ __forceinline__ void unpack8h(u32x4 w, float* f) { f[0] = h_lo(w.x); f[1] = h_hi(w.x); f[2] = h_lo(w.y); f[3] = h_hi(w.y); f[4] = h_lo(w.z); f[5] = h_hi(w.z); f[6] = h_lo(w.w); f[7] = h_hi(w.w); }
__device__ __forceinline__ float sigmoidf_(float z) { return __builtin_amdgcn_rcpf(1.f + __expf(-z)); }
__device__ __forceinline__ float siluf_(float z) { return z * sigmoidf_(z); }
__device__ __forceinline__ float wave_sum(float v) {
#pragma unroll
    for (int o = 1; o < 64; o <<= 1) v += __shfl_xor(v, o);
    return v;
}
__device__ __forceinline__ void rope_sc(int pos, int i, float& s, float& c) {
    const float ang = (float)pos * ROPE_INVF[i];
    double rev = (double)ang * 0.15915494309189535;
    rev -= __builtin_floor(rev);
    const float fr = (float)rev;
    s = __builtin_amdgcn_sinf(fr); c = __builtin_amdgcn_cosf(fr);
}
__device__ __forceinline__ void rope8(f32x4& v0, f32x4& v1, int pos, int i0) {
    float s, c, a, b;
    rope_sc(pos, i0, s, c);     a = v0[0]; b = v0[1]; v0[0] = a * c - b * s; v0[1] = b * c + a * s;
    rope_sc(pos, i0 + 1, s, c); a = v0[2]; b = v0[3]; v0[2] = a * c - b * s; v0[3] = b * c + a * s;
    rope_sc(pos, i0 + 2, s, c); a = v1[0]; b = v1[1]; v1[0] = a * c - b * s; v1[1] = b * c + a * s;
    rope_sc(pos, i0 + 3, s, c); a = v1[2]; b = v1[3]; v1[2] = a * c - b * s; v1[3] = b * c + a * s;
}

namespace pg8 {
__device__ __forceinline__ float row_rstd(const float* ssx, int row) {
    const f32x4 s0 = *(const f32x4*)(ssx + (size_t)row * 16), s1 = *(const f32x4*)(ssx + (size_t)row * 16 + 4), s2 = *(const f32x4*)(ssx + (size_t)row * 16 + 8), s3 = *(const f32x4*)(ssx + (size_t)row * 16 + 12);
    const float t = (((s0[0] + s0[1]) + (s0[2] + s0[3])) + ((s1[0] + s1[1]) + (s1[2] + s1[3]))) + (((s2[0] + s2[1]) + (s2[2] + s2[3])) + ((s3[0] + s3[1]) + (s3[2] + s3[3])));
    return __builtin_amdgcn_rsqf(t * (1.0f / 1024.0f) + NORM_EPS);
}
struct EpiMlaIn {
    static constexpr bool PERM = true, AFTER_DRAIN = false;
    unsigned char* ws; const int* pos;
    __device__ __forceinline__ void operator()(const f32x4 (&acc)[2][2][4][2], const Unit& u, int wr, int wc, int fr, int fq) const {
        const int ct = u.pn; const int row0 = u.pm * BM + wr * 64 + fr;
        bf16_t* qlat = (bf16_t*)(ws + WS_QLAT); bf16_t* kvlat = (bf16_t*)(ws + WS_KVLAT); bf16_t* krope = (bf16_t*)(ws + WS_KROPE); bf16_t* gate = (bf16_t*)(ws + WS_GATE); float* ssq = (float*)(ws + WS_SSQ);
#pragma unroll
        for (int ai = 0; ai < 2; ++ai)
#pragma unroll
            for (int m = 0; m < 4; ++m) {
                const int row = row0 + ai * HALF + m * 16;
                const float rs = row_rstd((const float*)(ws + WS_SSX), row);
                if (ct <= 3) {
                    float s = 0.f;
#pragma unroll
                    for (int bj = 0; bj < 2; ++bj) { const f32x4 v0 = acc[ai][bj][m][0] * rs, v1 = acc[ai][bj][m][1] * rs; const int cc = bj * HALF + wc * 32 + 8 * fq;
                        s += (v0[0] * v0[0] + v0[1] * v0[1]) + (v0[2] * v0[2] + v0[3] * v0[3]) + (v1[0] * v1[0] + v1[1] * v1[1]) + (v1[2] * v1[2] + v1[3] * v1[3]);
                        if (ct < 3) *(u32x4*)(qlat + (size_t)row * 768 + ct * 256 + cc) = pack8bf(v0, v1);
                        else *(u32x4*)(kvlat + (size_t)row * 256 + cc) = pack8bf(v0, v1); }
                    s += __shfl_xor(s, 16); s += __shfl_xor(s, 32);
                    if (fq == 0) ssq[(size_t)row * 16 + ct * 4 + wc] = s;
                } else if (ct == 4) {
                    if (wc < 2) { f32x4 v0 = acc[ai][0][m][0] * rs, v1 = acc[ai][0][m][1] * rs; const int cc = wc * 32 + 8 * fq;
                        rope8(v0, v1, pos[row], cc >> 1);
                        *(u32x4*)(krope + (size_t)row * 64 + cc) = pack8bf(v0, v1); }
                } else {
#pragma unroll
                    for (int bj = 0; bj < 2; ++bj) { f32x4 v0 = acc[ai][bj][m][0] * rs, v1 = acc[ai][bj][m][1] * rs; const int cc = bj * HALF + wc * 32 + 8 * fq;
#pragma unroll
                        for (int e = 0; e < 4; ++e) { v0[e] = siluf_(v0[e]); v1[e] = siluf_(v1[e]); }
                        *(u32x4*)(gate + (size_t)row * 1024 + (ct - 5) * 256 + cc) = pack8bf(v0, v1); }
                }
            }
    }
};
struct EpiUq {
    static constexpr bool PERM = true, AFTER_DRAIN = false;
    unsigned char* ws; const int* pos;
    __device__ __forceinline__ void operator()(const f32x4 (&acc)[2][2][4][2], const Unit& u, int wr, int wc, int fr, int fq) const {
        const int ct = u.pn; const int row0 = u.pm * BM + wr * 64 + fr; bf16_t* q = (bf16_t*)(ws + WS_Q); const float* ssq = (const float*)(ws + WS_SSQ);
#pragma unroll
        for (int ai = 0; ai < 2; ++ai)
#pragma unroll
            for (int m = 0; m < 4; ++m) {
                const int row = row0 + ai * HALF + m * 16;
                float ssum;
                { const f32x4 s0 = *(const f32x4*)(ssq + (size_t)row * 16), s1 = *(const f32x4*)(ssq + (size_t)row * 16 + 4), s2 = *(const f32x4*)(ssq + (size_t)row * 16 + 8);
                  ssum = (((s0[0] + s0[1]) + (s0[2] + s0[3])) + ((s1[0] + s1[1]) + (s1[2] + s1[3]))) + ((s2[0] + s2[1]) + (s2[2] + s2[3])); }
                const float rs = __builtin_amdgcn_rsqf(ssum * (1.0f / 768.0f) + NORM_EPS);
                int ps = 0; if (ct >= 4) ps = pos[row];
#pragma unroll
                for (int bj = 0; bj < 2; ++bj) { f32x4 v0 = acc[ai][bj][m][0] * rs, v1 = acc[ai][bj][m][1] * rs; const int cc = bj * HALF + wc * 32 + 8 * fq;
                    if (ct < 4) { const int col = ct * 256 + cc, h = col >> 7, d = col & 127;
                        *(u32x4*)(q + (size_t)row * 1536 + h * 192 + d) = pack8bf(v0, v1); }
                    else { const int col = (ct - 4) * 256 + cc, h = col >> 6, p = col & 63;
                        rope8(v0, v1, ps, p >> 1);
                        *(u32x4*)(q + (size_t)row * 1536 + h * 192 + 128 + p) = pack8bf(v0, v1); } }
            }
    }
};
struct EpiUkv {
    static constexpr bool PERM = true, AFTER_DRAIN = false;
    unsigned char* ws;
    __device__ __forceinline__ void operator()(const f32x4 (&acc)[2][2][4][2], const Unit& u, int wr, int wc, int fr, int fq) const {
        const int row0 = u.pm * BM + wr * 64 + fr; bf16_t* kn = (bf16_t*)(ws + WS_KN); bf16_t* v = (bf16_t*)(ws + WS_V); const float* ssq = (const float*)(ws + WS_SSQ);
#pragma unroll
        for (int ai = 0; ai < 2; ++ai)
#pragma unroll
            for (int m = 0; m < 4; ++m) {
                const int row = row0 + ai * HALF + m * 16;
                const f32x4 s3 = *(const f32x4*)(ssq + (size_t)row * 16 + 12);
                const float rs = __builtin_amdgcn_rsqf(((s3[0] + s3[1]) + (s3[2] + s3[3])) * (1.0f / 256.0f) + NORM_EPS);
                const size_t off = (size_t)row * 1024 + u.pn * 128 + wc * 32 + 8 * fq;
                *(u32x4*)(kn + off) = pack8bf(acc[ai][0][m][0] * rs, acc[ai][0][m][1] * rs);
                *(u32x4*)(v + off) = pack8bf(acc[ai][1][m][0] * rs, acc[ai][1][m][1] * rs);
            }
    }
};
struct EpiResid {
    static constexpr bool PERM = true, AFTER_DRAIN = false;
    bf16_t* xb; float* ssx; float* xf;
    __device__ __forceinline__ void operator()(const f32x4 (&acc)[2][2][4][2], const Unit& u, int wr, int wc, int fr, int fq) const {
        const int row0 = u.pm * BM + wr * 64 + fr;
#pragma unroll
        for (int ai = 0; ai < 2; ++ai)
#pragma unroll
            for (int m = 0; m < 4; ++m) { const int row = row0 + ai * HALF + m * 16; float s = 0.f;
#pragma unroll
                for (int bj = 0; bj < 2; ++bj) { const size_t off = (size_t)row * DM + u.pn * BM + bj * HALF + wc * 32 + 8 * fq;
                    const u32x4 xw = *(const u32x4*)(xb + off);
                    f32x4 v0 = acc[ai][bj][m][0], v1 = acc[ai][bj][m][1];
                    v0[0] += bf_lo(xw.x); v0[1] += bf_hi(xw.x); v0[2] += bf_lo(xw.y); v0[3] += bf_hi(xw.y); v1[0] += bf_lo(xw.z); v1[1] += bf_hi(xw.z); v1[2] += bf_lo(xw.w); v1[3] += bf_hi(xw.w);
                    if (xf) { *(f32x4*)(xf + off) = v0; *(f32x4*)(xf + off + 4) = v1; }
                    else { const u32x4 ow = pack8bf(v0, v1); *(u32x4*)(xb + off) = ow;
                        const float a0 = bf_lo(ow.x), a1 = bf_hi(ow.x), a2 = bf_lo(ow.y), a3 = bf_hi(ow.y), a4 = bf_lo(ow.z), a5 = bf_hi(ow.z), a6 = bf_lo(ow.w), a7 = bf_hi(ow.w);
                        s += ((a0 * a0 + a1 * a1) + (a2 * a2 + a3 * a3)) + ((a4 * a4 + a5 * a5) + (a6 * a6 + a7 * a7)); } }
                if (!xf) { s += __shfl_xor(s, 16); s += __shfl_xor(s, 32); if (fq == 0) ssx[(size_t)row * 16 + u.pn * 4 + wc] = s; } }
    }
};
struct EpiRwkvIn {
    static constexpr bool PERM = true, AFTER_DRAIN = false;
    unsigned char* ws;
    __device__ __forceinline__ void operator()(const f32x4 (&acc)[2][2][4][2], const Unit& u, int wr, int wc, int fr, int fq) const {
        const int ct = u.pn; const int row0 = u.pm * BM + wr * 64 + fr; bf16_t* pr = (bf16_t*)(ws + WS_PR); float* laraw = (float*)(ws + WS_LARAW);
#pragma unroll
        for (int ai = 0; ai < 2; ++ai)
#pragma unroll
            for (int m = 0; m < 4; ++m) {
                const int row = row0 + ai * HALF + m * 16;
                const float rs = row_rstd((const float*)(ws + WS_SSX), row);
                if (ct < 16) {
#pragma unroll
                    for (int bj = 0; bj < 2; ++bj) { const int cc = bj * HALF + wc * 32 + 8 * fq; *(u32x4*)(pr + (size_t)row * 4096 + ct * 256 + cc) = pack8bf(acc[ai][bj][m][0] * rs, acc[ai][bj][m][1] * rs); }
                } else { const int cc = wc * 32 + 8 * fq; float* d = laraw + (size_t)row * 128 + cc; *(f32x4*)d = acc[ai][0][m][0] * rs; *(f32x4*)(d + 4) = acc[ai][0][m][1] * rs; }
            }
    }
};
struct EpiLora {
    static constexpr bool PERM = true, AFTER_DRAIN = false;
    unsigned char* ws; const float* w0; const float* a0;
    __device__ __forceinline__ void operator()(const f32x4 (&acc)[2][2][4][2], const Unit& u, int wr, int wc, int fr, int fq) const {
        const int ct = u.pn; const int row0 = u.pm * BM + wr * 64 + fr; _Float16* E = (_Float16*)(ws + WS_E); _Float16* A = (_Float16*)(ws + WS_A);
        const bool isw = ct < 4; const float* bias = isw ? w0 : a0; _Float16* dst = isw ? E : A; const float mul = isw ? 0.6065306597126334f : 1.0f;
        const int cb = (isw ? ct : ct - 4) * 256 + wc * 32 + 8 * fq;
#pragma unroll
        for (int bj = 0; bj < 2; ++bj) { const int c = cb + bj * HALF;
            const f32x4 b0 = *(const f32x4*)(bias + c), b1 = *(const f32x4*)(bias + c + 4);
#pragma unroll
            for (int ai = 0; ai < 2; ++ai)
#pragma unroll
                for (int m = 0; m < 4; ++m) { const int row = row0 + ai * HALF + m * 16;
                    f32x4 v0 = acc[ai][bj][m][0] + b0, v1 = acc[ai][bj][m][1] + b1;
#pragma unroll
                    for (int e = 0; e < 4; ++e) { v0[e] = sigmoidf_(v0[e]) * mul; v1[e] = sigmoidf_(v1[e]) * mul; }
                    *(u32x4*)(dst + (size_t)row * 1024 + c) = pack8h(v0, v1); } }
    }
};
}

#define LASF __attribute__((address_space(3)))
__device__ __forceinline__ int il64(int i) { return 2 * (i & 31) + (i >> 5); }
__device__ __forceinline__ int rowmap(int mode, int n) {
    if (mode == 1) return n < 1024 ? n : (n < 1088 ? 1024 + il64(n - 1024) : n + 192);
    if (mode == 2) { const int h = n / 192, w = n - h * 192; return w < 128 ? h * 128 + w : 1024 + h * 64 + il64(w - 128); }
    if (mode == 3) return n + 1024;
    return n;
}
__device__ __forceinline__ void transpose_item(const float* W, int N, bf16_t* WT, int ldk, float* scr, int item, int lane, const float* kscale, float gscale, int mode) {
    const int nblk = N / 32, kb = item / nblk, nb = item - kb * nblk, k0 = 64 * kb, n0 = 32 * nb;
#pragma unroll 8
    for (int i = 0; i < 32; ++i) { const int kk = 2 * i + (lane >> 5); const float sc = kscale ? kscale[k0 + kk] * gscale : gscale;
        scr[kk * 33 + (lane & 31)] = W[(size_t)(k0 + kk) * N + n0 + (lane & 31)] * sc; }
    asm volatile("s_waitcnt lgkmcnt(0)" ::: "memory");
    const int c = lane & 7;
#pragma unroll
    for (int j = 0; j < 4; ++j) { const int n = (lane >> 3) + 8 * j; const float* s = scr + (8 * c) * 33 + n;
        u32x4 o; o.x = cvtpk(s[0 * 33], s[1 * 33]); o.y = cvtpk(s[2 * 33], s[3 * 33]); o.z = cvtpk(s[4 * 33], s[5 * 33]); o.w = cvtpk(s[6 * 33], s[7 * 33]);
        *(u32x4*)(WT + (size_t)rowmap(mode, n0 + n) * ldk + k0 + 8 * c) = o; }
    asm volatile("s_waitcnt lgkmcnt(0)" ::: "memory");
}
struct Args { const void* in[22]; float* out; unsigned char* ws; int ph_lo, ph_hi; };

template <class AP> __device__ __forceinline__ void prep_weights(AP ap, unsigned char* lds, int wave, int lane, int gw, int ngw) {
    float* scr = (float*)(lds + wave * 16384);
    constexpr int PER = 5088;
    const float QSCALE = 0.07216878364870322f * 1.4426950408889634f;
#pragma nounroll
    for (int it = gw; it < 2 * PER; it += ngw) {
        const int j = it / PER; int r = it - j * PER;
        unsigned char* mb = ap->ws + WS_W + (size_t)j * SZ_MLA; unsigned char* rb = ap->ws + WS_W + 2 * SZ_MLA + (size_t)j * SZ_RWKV;
        const float* W; int N; bf16_t* WT; int ldk; const float* ks = nullptr; float gs = 1.f; int mode = 0;
        if (r < 1056) { W = (const float*)ap->in[3] + (size_t)j * 1024 * 2112; N = 2112; WT = (bf16_t*)mb; ldk = 1024; ks = (const float*)ap->in[2] + (2 * j) * 1024; mode = 1; }
        else if ((r -= 1056) < 576) { W = (const float*)ap->in[5] + (size_t)j * 768 * 1536; N = 1536; WT = (bf16_t*)(mb + SZ_MWIN); ldk = 768; ks = (const float*)ap->in[4] + j * 768; gs = QSCALE; mode = 2; }
        else if ((r -= 576) < 256) { W = (const float*)ap->in[7] + (size_t)j * 256 * 2048; N = 2048; WT = (bf16_t*)(mb + SZ_MWIN + SZ_MWUQ); ldk = 256; ks = (const float*)ap->in[6] + j * 256; }
        else if ((r -= 256) < 512) { W = (const float*)ap->in[8] + (size_t)j * 1024 * 1024; N = 1024; WT = (bf16_t*)(mb + SZ_MWIN + SZ_MWUQ + SZ_MWUKV); ldk = 1024; }
        else if ((r -= 512) < 2112) { W = (const float*)ap->in[9] + (size_t)j * 1024 * 4224; N = 4224; WT = (bf16_t*)rb; ldk = 1024; ks = (const float*)ap->in[2] + (2 * j + 1) * 1024; }
        else if ((r -= 2112) < 32) { W = (const float*)ap->in[12] + (size_t)j * 64 * 1024; N = 1024; WT = (bf16_t*)(rb + SZ_RWIN); ldk = 128; }
        else if ((r -= 32) < 32) { W = (const float*)ap->in[14] + (size_t)j * 64 * 1024; N = 1024; WT = (bf16_t*)(rb + SZ_RWIN) + 64; ldk = 128; mode = 3; }
        else { r -= 32; W = (const float*)ap->in[20] + (size_t)j * 1024 * 1024; N = 1024; WT = (bf16_t*)(rb + SZ_RWIN + SZ_RWL); ldk = 1024; }
        transpose_item(W, N, WT, ldk, scr, r, lane, ks, gs, mode);
    }
    const int gt = gw * 64 + lane, ngt = ngw * 64;
    constexpr int Z0 = 24576, Z1 = 16384, Z2 = 16384, ZT = Z0 + Z1 + Z2;
    unsigned zz = 0u; asm volatile("" : "+v"(zz)); const u32x4 z = {zz, zz, zz, zz};
    for (int it = gt; it < 2 * ZT; it += ngt) {
        const int j = it / ZT; int r = it - j * ZT;
        unsigned char* mb = ap->ws + WS_W + (size_t)j * SZ_MLA; unsigned char* rb = ap->ws + WS_W + 2 * SZ_MLA + (size_t)j * SZ_RWKV;
        if (r < Z0) *(u32x4*)(mb + (size_t)1088 * 2048 + (size_t)r * 16) = z;
        else if ((r -= Z0) < Z1) *(u32x4*)(rb + (size_t)4224 * 2048 + (size_t)r * 16) = z;
        else { r -= Z1; const int row = r >> 3, u = r & 7; *(u32x4*)(rb + SZ_RWIN + (size_t)row * 256 + (row < 1024 ? 128 : 0) + u * 16) = z; }
    }
}

__device__ __forceinline__ void conv_rows_bf16(const float* X, bf16_t* XB, float* ssx, int gw, int ngw, int lane) {
    f32x4 cur[4], nxt[4];
    if (gw < T) {
#pragma unroll
        for (int j = 0; j < 4; ++j) cur[j] = ((const f32x4*)(X + (size_t)gw * DM) + lane)[64 * j]; }
    for (int m = gw; m < T; m += ngw) {
        const int mn = m + ngw < T ? m + ngw : m;
#pragma unroll
        for (int j = 0; j < 4; ++j) nxt[j] = ((const f32x4*)(X + (size_t)mn * DM) + lane)[64 * j];
        unsigned long long* o8 = (unsigned long long*)(XB + (size_t)m * DM) + lane; float s = 0.f;
#pragma unroll
        for (int j = 0; j < 4; ++j) { const f32x4 v = cur[j]; const unsigned w0 = cvtpk(v[0], v[1]), w1 = cvtpk(v[2], v[3]);
            const float a0 = bf_lo(w0), a1 = bf_hi(w0), a2 = bf_lo(w1), a3 = bf_hi(w1); s += (a0 * a0 + a1 * a1) + (a2 * a2 + a3 * a3);
            o8[64 * j] = (unsigned long long)w0 | ((unsigned long long)w1 << 32); }
        s = wave_sum(s);
        if (lane < 16) ssx[(size_t)m * 16 + lane] = lane == 0 ? s : 0.f;
#pragma unroll
        for (int j = 0; j < 4; ++j) cur[j] = nxt[j];
    }
}
__device__ __forceinline__ void final_norm(const float* X, float* out, const float* g, int gw, int ngw, int lane) {
    f32x4 gv[4], cur[4], nxt[4];
#pragma unroll
    for (int j = 0; j < 4; ++j) gv[j] = ((const f32x4*)g)[lane + 64 * j];
    if (gw < T) {
#pragma unroll
        for (int j = 0; j < 4; ++j) cur[j] = ((const f32x4*)(X + (size_t)gw * DM) + lane)[64 * j]; }
    for (int m = gw; m < T; m += ngw) {
        const int mn = m + ngw < T ? m + ngw : m;
#pragma unroll
        for (int j = 0; j < 4; ++j) nxt[j] = ((const f32x4*)(X + (size_t)mn * DM) + lane)[64 * j];
        f32x4* orow = (f32x4*)(out + (size_t)m * DM) + lane; float s = 0.f;
#pragma unroll
        for (int j = 0; j < 4; ++j) s += (cur[j][0] * cur[j][0] + cur[j][1] * cur[j][1]) + (cur[j][2] * cur[j][2] + cur[j][3] * cur[j][3]);
        const float rstd = 1.0f / sqrtf(wave_sum(s) * (1.f / DM) + NORM_EPS);
#pragma unroll
        for (int j = 0; j < 4; ++j) orow[64 * j] = cur[j] * rstd * gv[j];
#pragma unroll
        for (int j = 0; j < 4; ++j) cur[j] = nxt[j];
    }
}

namespace att {
constexpr int KP = 400, KBUF = 64 * KP, VBUF = 16384;
constexpr int OFF_K = 0, OFF_V = 2 * KBUF, OFF_WS = OFF_V + 2 * VBUF, ATT_LDS = OFF_WS + 8 * 64 * 4;
static_assert(ATT_LDS <= 131072, "attention LDS");
constexpr float THR2 = 11.0f;
#define SBAR() __builtin_amdgcn_sched_barrier(0)
__device__ __forceinline__ int v_st(int k, int c) { const int kk = (k & ~0xC) | ((k & 4) << 1) | ((k & 8) >> 1); return ((kk >> 3) * 4 + (c >> 5)) * 512 + ((kk & 7) * 32 + (c & 31)) * 2; }
__device__ __forceinline__ int v_rd_base(int lane) { return ((lane & 3) << 3) | (((lane >> 2) & 3) << 6) | (((lane >> 4) & 1) << 5) | (((lane >> 5) & 1) << 8); }
constexpr int v_rd_off(int d0, int ks, int half) { return d0 * 512 + ks * 4096 + half * 2048; }
__device__ __forceinline__ int crow(int r, int hi) { return (r & 3) + 8 * (r >> 2) + 4 * hi; }

__device__ __forceinline__ void mask_tile(f32x16& p0, f32x16& p1, int dq) {
    const float NEG = -__builtin_inff();
#pragma unroll
    for (int r = 0; r < 16; ++r) {
        const int c = (r & 3) + 8 * (r >> 2);
        if (dq - c < 0) p0[r] = NEG;
        if (dq - c - 32 < 0) p1[r] = NEG;
    }
}
__device__ __forceinline__ void softmax_tile(f32x16& p0, f32x16& p1, float& m_reg, float& l_reg, float& alpha, bf16x8& pa0, bf16x8& pa1, bf16x8& pa2, bf16x8& pa3) {
    float pmax = p0[0];
#pragma unroll
    for (int r = 1; r < 16; ++r) pmax = fmaxf(pmax, p0[r]);
#pragma unroll
    for (int r = 0; r < 16; ++r) pmax = fmaxf(pmax, p1[r]);
    { auto rr = __builtin_amdgcn_permlane32_swap(__float_as_uint(pmax), __float_as_uint(pmax), false, false);
      pmax = fmaxf(__uint_as_float(rr[0]), __uint_as_float(rr[1])); }
    float mn;
    if (__builtin_expect(__all((pmax - m_reg) <= THR2), 1)) { mn = m_reg; alpha = 1.f; }
    else { mn = fmaxf(m_reg, pmax); alpha = __builtin_amdgcn_exp2f(m_reg - mn); m_reg = mn; }
#pragma unroll
    for (int r = 0; r < 16; ++r) p0[r] = __builtin_amdgcn_exp2f(p0[r] - mn);
#pragma unroll
    for (int r = 0; r < 16; ++r) p1[r] = __builtin_amdgcn_exp2f(p1[r] - mn);
    f32x2 ps2 = {0.f, 0.f};
#pragma unroll
    for (int r = 0; r < 16; r += 2) { ps2 += (f32x2){p0[r], p0[r + 1]}; ps2 += (f32x2){p1[r], p1[r + 1]}; }
    float ps = ps2[0] + ps2[1];
    { auto rr = __builtin_amdgcn_permlane32_swap(__float_as_uint(ps), __float_as_uint(ps), false, false);
      ps = __uint_as_float(rr[0]) + __uint_as_float(rr[1]); }
    l_reg = l_reg * alpha + ps;
#define PK4(P, B_, OUT) do { unsigned a0 = cvtpk(P[B_+0], P[B_+1]), a1 = cvtpk(P[B_+2], P[B_+3]);                          \
        unsigned b0 = cvtpk(P[B_+4], P[B_+5]), b1 = cvtpk(P[B_+6], P[B_+7]);                                             \
        auto r0 = __builtin_amdgcn_permlane32_swap(a0, b0, false, false); auto r1 = __builtin_amdgcn_permlane32_swap(a1, b1, false, false); \
        u32x4 w = {r0[0], r1[0], r0[1], r1[1]}; OUT = *reinterpret_cast<bf16x8*>(&w); } while (0)
    PK4(p0, 0, pa0); PK4(p0, 8, pa1); PK4(p1, 0, pa2); PK4(p1, 8, pa3);
#undef PK4
}
template <int KB>
__device__ __forceinline__ void qkt(f32x16& p0, f32x16& p1, const char* K_lds, int r32, int hi, const bf16x8* qr) {
    p0 = f32x16{}; p1 = f32x16{};
    const int kaddr = (int)(uintptr_t)K_lds + r32 * KP + hi * 16;
    bf16x8 f0, f1, f2, f3;
#define KRD(dst, i) asm volatile("ds_read_b128 %0, %1 offset:%2" : "=v"(dst) : "v"(kaddr), "i"(KB * KBUF + ((i) >> 1) * 32 + ((i) & 1) * 32 * KP) : "memory")
#define KMM(f, i, W) do { asm volatile("s_waitcnt lgkmcnt(%1)" : "+v"(f) : "n"(W) : "memory"); \
        if ((i) & 1) p1 = __builtin_amdgcn_mfma_f32_32x32x16_bf16(f, qr[(i) >> 1], p1, 0, 0, 0); else p0 = __builtin_amdgcn_mfma_f32_32x32x16_bf16(f, qr[(i) >> 1], p0, 0, 0, 0); \
        if ((i) + 4 < 24) KRD(f, (i) + 4); } while (0)
    KRD(f0, 0); KRD(f1, 1); KRD(f2, 2); KRD(f3, 3);
    KMM(f0, 0, 3); KMM(f1, 1, 3); KMM(f2, 2, 3); KMM(f3, 3, 3); KMM(f0, 4, 3); KMM(f1, 5, 3); KMM(f2, 6, 3); KMM(f3, 7, 3);
    KMM(f0, 8, 3); KMM(f1, 9, 3); KMM(f2, 10, 3); KMM(f3, 11, 3); KMM(f0, 12, 3); KMM(f1, 13, 3); KMM(f2, 14, 3); KMM(f3, 15, 3);
    KMM(f0, 16, 3); KMM(f1, 17, 3); KMM(f2, 18, 3); KMM(f3, 19, 3); KMM(f0, 20, 3); KMM(f1, 21, 2); KMM(f2, 22, 1); KMM(f3, 23, 0);
#undef KMM
#undef KRD
}
template <int VB>
__device__ __forceinline__ void pv_tile(f32x16* o, int vb0, bf16x8 pa0, bf16x8 pa1, bf16x8 pa2, bf16x8 pa3) {
#define TRRD(dst, off) asm volatile("ds_read_b64_tr_b16 %0, %1 offset:%2" : "=v"(dst) : "v"(vb0), "i"(off) : "memory")
#define PV_RD(S, d0) do { constexpr int b_ = VB * VBUF + v_rd_off(d0, 0, 0); \
        TRRD(S##l0, b_); TRRD(S##h0, b_ + 2048); TRRD(S##l1, b_ + 4096); TRRD(S##h1, b_ + 6144); TRRD(S##l2, b_ + 8192); TRRD(S##h2, b_ + 10240); TRRD(S##l3, b_ + 12288); TRRD(S##h3, b_ + 14336); } while (0)
#define PV_MM(S, d0, W) do { asm volatile("s_waitcnt lgkmcnt(%8)" : "+v"(S##l0), "+v"(S##h0), "+v"(S##l1), "+v"(S##h1), "+v"(S##l2), "+v"(S##h2), "+v"(S##l3), "+v"(S##h3) : "n"(W) : "memory"); \
        o[d0] = __builtin_amdgcn_mfma_f32_32x32x16_bf16(pa0, (bf16x8){S##l0[0], S##l0[1], S##l0[2], S##l0[3], S##h0[0], S##h0[1], S##h0[2], S##h0[3]}, o[d0], 0, 0, 0);   \
        o[d0] = __builtin_amdgcn_mfma_f32_32x32x16_bf16(pa1, (bf16x8){S##l1[0], S##l1[1], S##l1[2], S##l1[3], S##h1[0], S##h1[1], S##h1[2], S##h1[3]}, o[d0], 0, 0, 0);   \
        o[d0] = __builtin_amdgcn_mfma_f32_32x32x16_bf16(pa2, (bf16x8){S##l2[0], S##l2[1], S##l2[2], S##l2[3], S##h2[0], S##h2[1], S##h2[2], S##h2[3]}, o[d0], 0, 0, 0);   \
        o[d0] = __builtin_amdgcn_mfma_f32_32x32x16_bf16(pa3, (bf16x8){S##l3[0], S##l3[1], S##l3[2], S##l3[3], S##h3[0], S##h3[1], S##h3[2], S##h3[3]}, o[d0], 0, 0, 0); } while (0)
    s16x4 Al0, Al1, Al2, Al3, Ah0, Ah1, Ah2, Ah3, Bl0, Bl1, Bl2, Bl3, Bh0, Bh1, Bh2, Bh3;
    PV_RD(A, 0); PV_RD(B, 1);
    PV_MM(A, 0, 8); PV_RD(A, 2);
    PV_MM(B, 1, 8); PV_RD(B, 3);
    PV_MM(A, 2, 8);
    PV_MM(B, 3, 0);
#undef PV_MM
#undef PV_RD
#undef TRRD
}
__device__ __forceinline__ void attn_unit(int b, int h, int qb, const bf16_t* Q, const bf16_t* KN, const bf16_t* KR, const bf16_t* V, const bf16_t* G, bf16_t* O, char* lds) {
    int tid_ = threadIdx.x; asm volatile("" : "+v"(tid_));
    const int tid = tid_, wid = __builtin_amdgcn_readfirstlane(tid >> 6), lane = tid & 63, r32 = lane & 31, hi = lane >> 5;
    const size_t rowbase = (size_t)b * SEQ; const int q0 = qb * 256;
    char* V_lds = lds + OFF_V; char* K_lds = lds + OFF_K;
    float* wsf = (float*)(lds + OFF_WS) + wid * 64; float* li_l = wsf; float* al_l = wsf + 32;
    const int NT = (q0 + 256) / 64;
    const int qlo = q0 + wid * 32, qm = qlo + r32 - 4 * hi;
    const int sr = tid >> 4, sc = (tid & 15) * 8, vst0 = v_st(sr, sc), vst1 = v_st(32 + sr, sc), kws = sr * KP + sc * 2;
    const int rr = tid >> 3, rc = (tid & 7) * 8, krs = rr * KP + 256 + rc * 2;
    const int vb0 = (int)(uintptr_t)V_lds + v_rd_base(lane);
    const bf16_t* Kh = KN + rowbase * 1024 + h * 128 + sc; const bf16_t* Vh = V + rowbase * 1024 + h * 128 + sc; const bf16_t* Rh = KR + rowbase * 64 + rc;
    bf16x8 qr[12];
    { const bf16_t* qp = Q + (rowbase + qlo + r32) * 1536 + h * 192 + hi * 8;
#pragma unroll
      for (int d0 = 0; d0 < 12; ++d0) qr[d0] = *reinterpret_cast<const bf16x8*>(qp + d0 * 16); }
    bf16x8 sk0, sk1, skr, sv0, sv1;
#define LOADG(t) do { const size_t k0_ = (size_t)(t) * 64; sk0 = *(const bf16x8*)(Kh + (k0_ + sr) * 1024); sk1 = *(const bf16x8*)(Kh + (k0_ + 32 + sr) * 1024); \
        skr = *(const bf16x8*)(Rh + (k0_ + rr) * 64); sv0 = *(const bf16x8*)(Vh + (k0_ + sr) * 1024); sv1 = *(const bf16x8*)(Vh + (k0_ + 32 + sr) * 1024); } while (0)
#define WRITEL(bf) do { *(bf16x8*)(K_lds + (bf) * KBUF + kws) = sk0; *(bf16x8*)(K_lds + (bf) * KBUF + kws + 32 * KP) = sk1; *(bf16x8*)(K_lds + (bf) * KBUF + krs) = skr; \
        *(bf16x8*)(V_lds + (bf) * VBUF + vst0) = sv0; *(bf16x8*)(V_lds + (bf) * VBUF + vst1) = sv1; } while (0)
    float m_reg = -1e30f, l_reg = 0.f; f32x16 o[4] = {};
    f32x16 p0, p1; bf16x8 pa0, pa1, pa2, pa3; float alpha;
    LOADG(0); WRITEL(0); LOADG(1); __syncthreads();
#define STEP(BUF, t) do { \
        if ((t) + 1 < NT) WRITEL((BUF) ^ 1); \
        if ((t) + 2 < NT) LOADG((t) + 2); \
        if ((t) * 64 <= qlo + 31) {     \
        SBAR(); __builtin_amdgcn_s_setprio(1); qkt<BUF>(p0, p1, K_lds, r32, hi, qr); __builtin_amdgcn_s_setprio(0); \
        { const int kb_ = (t) * 64; if (kb_ + 63 > qlo) mask_tile(p0, p1, qm - kb_); } \
        softmax_tile(p0, p1, m_reg, l_reg, alpha, pa0, pa1, pa2, pa3); \
        if (__any(alpha < 1.f)) { if (hi == 0) al_l[r32] = alpha; asm volatile("s_waitcnt lgkmcnt(0)" ::: "memory"); \
            _Pragma("unroll") for (int d_ = 0; d_ < 4; ++d_) _Pragma("unroll") for (int r = 0; r < 16; ++r) o[d_][r] *= al_l[crow(r, hi)]; } \
        SBAR(); __builtin_amdgcn_s_setprio(1); pv_tile<BUF>(o, vb0, pa0, pa1, pa2, pa3); __builtin_amdgcn_s_setprio(0); } \
        __syncthreads(); } while (0)
    for (int t = 0; t < NT; t += 2) { STEP(0, t); STEP(1, t + 1); }
#undef STEP
#undef LOADG
#undef WRITEL
    if (hi == 0) li_l[r32] = l_reg; asm volatile("s_waitcnt lgkmcnt(0)" ::: "memory");
    const size_t obase = (rowbase + qlo) * 1024 + h * 128 + r32;
#pragma unroll
    for (int r = 0; r < 16; ++r) { const int orow = crow(r, hi); const float rli = __builtin_amdgcn_rcpf(li_l[orow]);
#pragma unroll
        for (int d0 = 0; d0 < 4; ++d0) { const size_t off = obase + (size_t)orow * 1024 + d0 * 32;
            const float gv = __uint_as_float(((unsigned)G[off]) << 16);
            const float v = o[d0][r] * rli * gv; const float vn = __shfl_xor(v, 1);
            if ((r32 & 1) == 0) *(unsigned*)(O + off) = cvtpk(v, vn); } }
    __syncthreads();
}
__device__ __forceinline__ void attn_phase(unsigned char* ws, char* lds, int vcu, int G_) {
    const bf16_t* Q = (const bf16_t*)(ws + WS_Q); const bf16_t* KN = (const bf16_t*)(ws + WS_KN); const bf16_t* KR = (const bf16_t*)(ws + WS_KROPE); const bf16_t* V = (const bf16_t*)(ws + WS_V); const bf16_t* G = (const bf16_t*)(ws + WS_GATE); bf16_t* O = (bf16_t*)(ws + WS_BUFA);
    for (int L = vcu; L < 1024; L += G_) { const int bh = L >> 4, x = L & 15;
        attn_unit(bh >> 3, bh & 7, 31 - x, Q, KN, KR, V, G, O, lds);
        attn_unit(bh >> 3, bh & 7, x, Q, KN, KR, V, G, O, lds); }
}
#undef SBAR
}

__device__ __forceinline__ float tanhf_(float x) { return 1.f - 2.f * __builtin_amdgcn_rcpf(__expf(2.f * x) + 1.f); }
__device__ __forceinline__ void lora_in_phase(const float* laraw, const float* mu  , bf16_t* la, int gt, int ngt) {
    for (int idx = gt; idx < T * 16; idx += ngt) {
        const int t = idx >> 4, g = idx & 15, c0 = g * 8; const int s = t & (SEQ - 1);
        const float* p = laraw + (size_t)t * 128 + c0;
        f32x4 r0 = *(const f32x4*)p, r1 = *(const f32x4*)(p + 4), q0 = {0.f, 0.f, 0.f, 0.f}, q1 = q0;
        if (s > 0) { q0 = *(const f32x4*)(p - 128); q1 = *(const f32x4*)(p - 124); }
        const f32x4 m0 = *(const f32x4*)(mu + 4096 + c0), m1 = *(const f32x4*)(mu + 4096 + c0 + 4);
        f32x4 v0 = r0 + m0 * (q0 - r0), v1 = r1 + m1 * (q1 - r1);
        if (g < 8) {
#pragma unroll
            for (int e = 0; e < 4; ++e) { v0[e] = tanhf_(v0[e]); v1[e] = tanhf_(v1[e]); } }
        *(u32x4*)(la + (size_t)t * 128 + c0) = pack8bf(v0, v1);
    }
}
namespace scan {
constexpr int STEP_F = 356, STEPB = STEP_F * 4, CH = 32, BUFB = CH * STEPB, OFF_Y = 2 * BUFB, YB = CH * 32 * 4, OFF_YD = OFF_Y + 2 * YB  , SCAN_LDS = OFF_YD + 512 * 4;
static_assert(SCAN_LDS <= 131072, "scan LDS");
template <int CTRL> __device__ __forceinline__ float dpp_add(float x) {
    return x + __builtin_bit_cast(float, __builtin_amdgcn_update_dpp(0, __builtin_bit_cast(int, x), CTRL, 0xf, 0xf, true));
}
__device__ __forceinline__ float allred16(float x) { x = dpp_add<0xB1>(x); x = dpp_add<0x4E>(x); x = dpp_add<0x141>(x); x = dpp_add<0x140>(x); return x; }

__device__ __forceinline__ void scan_item(int item, unsigned char* ws, const float* mu, const float* k_k, const float* k_a, const float* r_k, char* lds) {
    const bf16_t* PR = (const bf16_t*)(ws + WS_PR); const _Float16* E = (const _Float16*)(ws + WS_E); const _Float16* A = (const _Float16*)(ws + WS_A); bf16_t* Y = (bf16_t*)(ws + WS_BUFA); float* BON = (float*)(ws + WS_SSQ);
    int tid_ = threadIdx.x; asm volatile("" : "+v"(tid_));
    const int tid = tid_, wid = __builtin_amdgcn_readfirstlane(tid >> 6), lane = tid & 63;
    const int bh = item >> 1, half = item & 1, b = bh >> 4, h = bh & 15;
    const size_t rowbase = (size_t)b * SEQ;
    constexpr int NCH = SEQ / CH;
    typedef unsigned u32x2 __attribute__((ext_vector_type(2)));
    const int ls = tid >> 4, lq = tid & 15, c0 = h * 64 + lq * 4;
    const f32x4 mr = *(const f32x4*)(mu + c0), mk = *(const f32x4*)(mu + 1024 + c0), mv = *(const f32x4*)(mu + 2048 + c0), kkp = *(const f32x4*)(k_k + c0), kap = *(const f32x4*)(k_a + c0), rkp = *(const f32x4*)(r_k + c0);
    const bool myv = (lq >> 3) == half;
    u32x2 g_rt, g_kt, g_vt, g_rp, g_kp, g_vp, g_et, g_at;
#define SC_LOAD(cn) do { const int sg_ = (cn) * CH + ls; const bf16_t* pr_ = PR + (rowbase + sg_) * 4096 + c0; \
        g_rt = *(const u32x2*)pr_; g_kt = *(const u32x2*)(pr_ + 1024); g_vt = *(const u32x2*)(pr_ + 2048); \
        const bf16_t* pp_ = sg_ > 0 ? pr_ - 4096 : pr_; g_rp = *(const u32x2*)pp_; g_kp = *(const u32x2*)(pp_ + 1024); g_vp = *(const u32x2*)(pp_ + 2048); \
        g_et = *(const u32x2*)(E + (rowbase + sg_) * 1024 + c0); g_at = *(const u32x2*)(A + (rowbase + sg_) * 1024 + c0); } while (0)
#define SC_CVT(cn) do { const float pm_ = ((cn) * CH + ls) > 0 ? 1.f : 0.f; \
        f32x4 r_ = {bf_lo(g_rt.x), bf_hi(g_rt.x), bf_lo(g_rt.y), bf_hi(g_rt.y)}, k_ = {bf_lo(g_kt.x), bf_hi(g_kt.x), bf_lo(g_kt.y), bf_hi(g_kt.y)}, v_ = {bf_lo(g_vt.x), bf_hi(g_vt.x), bf_lo(g_vt.y), bf_hi(g_vt.y)}; \
        const f32x4 rq_ = (f32x4){bf_lo(g_rp.x), bf_hi(g_rp.x), bf_lo(g_rp.y), bf_hi(g_rp.y)} * pm_, kq_ = (f32x4){bf_lo(g_kp.x), bf_hi(g_kp.x), bf_lo(g_kp.y), bf_hi(g_kp.y)} * pm_, vq_ = (f32x4){bf_lo(g_vp.x), bf_hi(g_vp.x), bf_lo(g_vp.y), bf_hi(g_vp.y)} * pm_; \
        const f32x4 e_ = {h_lo(g_et.x), h_hi(g_et.x), h_lo(g_et.y), h_hi(g_et.y)}, a_ = {h_lo(g_at.x), h_hi(g_at.x), h_lo(g_at.y), h_hi(g_at.y)}; \
        r_ += mr * (rq_ - r_); k_ += mk * (kq_ - k_); v_ += mv * (vq_ - v_); \
        const f32x4 kkv_ = k_ * kkp; float ss_ = (kkv_[0] * kkv_[0] + kkv_[1] * kkv_[1]) + (kkv_[2] * kkv_[2] + kkv_[3] * kkv_[3]); ss_ = allred16(ss_); \
        const float inv_ = __builtin_amdgcn_rsqf(fmaxf(ss_, 1e-24f)); const f32x4 kk_ = kkv_ * inv_;     \
        float* st_ = (float*)(lds + ((cn) & 1) * BUFB + ls * STEPB) + lq * 4; \
        *(f32x4*)(st_) = -kk_; \
        *(f32x4*)(st_ + 64) = (f32x4){__expf(-e_[0]), __expf(-e_[1]), __expf(-e_[2]), __expf(-e_[3])}; \
        *(f32x4*)(st_ + 128) = kk_ * a_; \
        const f32x4 kf_ = k_ * ((a_ - 1.f) * kap + 1.f); *(f32x4*)(st_ + 192) = kf_; \
        if (half == 0) { const f32x4 bq_ = r_ * kf_ * rkp; float bn_ = allred16((bq_[0] + bq_[1]) + (bq_[2] + bq_[3])); if (lq == 0) BON[(rowbase + (size_t)(cn) * CH + ls) * 16 + h] = bn_; } \
        *(f32x4*)(st_ + 256) = r_; \
        if (myv) *(f32x4*)((float*)(lds + ((cn) & 1) * BUFB + ls * STEPB) + 320 + (lq & 7) * 4) = v_; } while (0)
#define SC_YOUT(cn) do { if (lq < 8) { const f32x4 y_ = *(const f32x4*)((const float*)(lds + OFF_Y + ((cn) & 1) * YB) + ls * 32 + lq * 4); \
        u32x2 o_; o_.x = cvtpk(y_[0], y_[1]); o_.y = cvtpk(y_[2], y_[3]); \
        *(u32x2*)(Y + (rowbase + (size_t)(cn) * CH + ls) * 1024 + h * 64 + half * 32 + lq * 4) = o_; } } while (0)
    const int cgp = lane & 15, row = wid * 4 + (lane >> 4);
    f32x4 S = {0.f, 0.f, 0.f, 0.f};
    SC_LOAD(0); SC_CVT(0);
    __syncthreads();
    for (int c = 0; c < NCH; ++c) {
        if (c > 0) SC_YOUT(c - 1);
        if (c + 1 < NCH) SC_LOAD(c + 1);
        const float* base = (const float*)(lds + (c & 1) * BUFB) + cgp * 4;
        const float* vbp = (const float*)(lds + (c & 1) * BUFB) + 320 + row;
        float* yb = (float*)(lds + OFF_Y + (c & 1) * YB) + row;
        float* ybw = cgp == 0 ? yb : (float*)(lds + OFF_YD) + wid * 64 + lane; const int ybs = cgp == 0 ? 32 : 0;
        f32x4 a4 = *(const f32x4*)(base), w4 = *(const f32x4*)(base + 64), b4 = *(const f32x4*)(base + 128), k4 = *(const f32x4*)(base + 192), r4 = *(const f32x4*)(base + 256);
        float v1 = *vbp; float ypart = 0.f;
#pragma unroll 4
        for (int s = 0; s < CH; ++s) {
            const int sn = s + 1;
            const float* st = base + sn * STEP_F;
            const f32x4 na4 = *(const f32x4*)(st), nw4 = *(const f32x4*)(st + 64), nb4 = *(const f32x4*)(st + 128), nk4 = *(const f32x4*)(st + 192), nr4 = *(const f32x4*)(st + 256);
            const float nv1 = vbp[sn * STEP_F];
            float p = (S[0] * a4[0] + S[1] * a4[1]) + (S[2] * a4[2] + S[3] * a4[3]);
            p = dpp_add<0xB1>(p); ypart = dpp_add<0xB1>(ypart); p = dpp_add<0x4E>(p); ypart = dpp_add<0x4E>(ypart);
            p = dpp_add<0x141>(p); ypart = dpp_add<0x141>(ypart); p = dpp_add<0x140>(p); ypart = dpp_add<0x140>(ypart);
            if (s > 0) ybw[(s - 1) * ybs] = ypart;
            S = S * w4 + (b4 * p + k4 * v1);
            ypart = (S[0] * r4[0] + S[1] * r4[1]) + (S[2] * r4[2] + S[3] * r4[3]);
            a4 = na4; w4 = nw4; b4 = nb4; k4 = nk4; r4 = nr4; v1 = nv1;
        }
        ypart = allred16(ypart);
        ybw[(CH - 1) * ybs] = ypart;
        if (c + 1 < NCH) SC_CVT(c + 1);
        __syncthreads();
    }
    SC_YOUT(NCH - 1);
    __syncthreads();
#undef SC_LOAD
#undef SC_CVT
#undef SC_YOUT
}
}

__device__ __forceinline__ void post_phase(unsigned char* ws, const float* mu, const float* ln_g, const float* ln_b, int gt, int ngt) {
    const bf16_t* PR = (const bf16_t*)(ws + WS_PR); bf16_t* Y = (bf16_t*)(ws + WS_BUFA); const float* BON = (const float*)(ws + WS_SSQ);
    const int g = gt & 127, c0 = g * 8;
    const f32x4 mv0 = *(const f32x4*)(mu + 2048 + c0), mv1 = *(const f32x4*)(mu + 2048 + c0 + 4), mg0 = *(const f32x4*)(mu + 3072 + c0), mg1 = *(const f32x4*)(mu + 3072 + c0 + 4);
    const f32x4 lg0 = *(const f32x4*)(ln_g + c0), lg1 = *(const f32x4*)(ln_g + c0 + 4), lb0 = *(const f32x4*)(ln_b + c0), lb1 = *(const f32x4*)(ln_b + c0 + 4);
    u32x4 n_vt, n_gt, n_vp, n_gp, n_yt; float n_bon;
#define POST_LOAD(ix) do { const int t_ = (ix) >> 7; const bf16_t* pr_ = PR + (size_t)t_ * 4096 + c0; const int pv_ = (t_ & (SEQ - 1)) > 0 ? 4096 : 0; \
        n_vt = *(const u32x4*)(pr_ + 2048); n_gt = *(const u32x4*)(pr_ + 3072); n_vp = *(const u32x4*)(pr_ - pv_ + 2048); n_gp = *(const u32x4*)(pr_ - pv_ + 3072); \
        n_yt = *(const u32x4*)(Y + (size_t)t_ * 1024 + c0); n_bon = BON[(size_t)t_ * 16 + (g >> 3)]; } while (0)
    if (gt < T * 128) POST_LOAD(gt);
    for (int idx = gt; idx < T * 128; idx += ngt) {
        const int t = idx >> 7; const int s = t & (SEQ - 1);
        const u32x4 vt = n_vt, gt_ = n_gt, yt = n_yt; u32x4 vp = n_vp, gp = n_gp; const float bon = n_bon;
        if (s == 0) { vp = (u32x4){0u, 0u, 0u, 0u}; gp = vp; }
        { const int nx = idx + ngt < T * 128 ? idx + ngt : idx; POST_LOAD(nx); }
        float v_[8], g_[8], vq[8], gq[8], y_[8];
        unpack8bf(vt, v_); unpack8bf(gt_, g_); unpack8bf(vp, vq); unpack8bf(gp, gq); unpack8bf(yt, y_);
        float ysum = 0.f;
#pragma unroll
        for (int e = 0; e < 8; ++e) { const float mve = e < 4 ? mv0[e & 3] : mv1[e & 3], mge = e < 4 ? mg0[e & 3] : mg1[e & 3];
            v_[e] += mve * (vq[e] - v_[e]); g_[e] += mge * (gq[e] - g_[e]); ysum += y_[e]; }
        ysum += __shfl_xor(ysum, 1); ysum += __shfl_xor(ysum, 2); ysum += __shfl_xor(ysum, 4);
        const float mean = ysum * (1.f / 64.f); float var = 0.f;
#pragma unroll
        for (int e = 0; e < 8; ++e) { const float d = y_[e] - mean; var += d * d; }
        var += __shfl_xor(var, 1); var += __shfl_xor(var, 2); var += __shfl_xor(var, 4);
        const float rstd = 1.0f / sqrtf(var * (1.f / 64.f) + GN_EPS);
        f32x4 o0, o1;
#pragma unroll
        for (int e = 0; e < 8; ++e) { const float lge = e < 4 ? lg0[e & 3] : lg1[e & 3], lbe = e < 4 ? lb0[e & 3] : lb1[e & 3];
            const float yn = (y_[e] - mean) * rstd * lge + lbe + bon * v_[e];
            const float ov = yn * siluf_(g_[e]);
            if (e < 4) o0[e] = ov; else o1[e - 4] = ov; }
        *(u32x4*)(Y + (size_t)t * 1024 + c0) = pack8bf(o0, o1);
    }
#undef POST_LOAD
}

#define LAS __attribute__((address_space(3)))
#define XB_TMO      128
#define XB_XCNT(j)  (256  + 64 * (j))
#define XB_XSUB(j)  (1280 + 64 * (j))
#define XB_XGEN(j)  (2304 + 64 * (j))
#define XB_TOP      3328
#define XB_TOPGEN   3392
#define XCD_BAR_WORDS 3456
#define XB_SPIN_CAP (1u << 18)

__device__ __forceinline__ unsigned xb_ld(unsigned* p)              { return __hip_atomic_load(p, __ATOMIC_RELAXED, __HIP_MEMORY_SCOPE_AGENT); }
__device__ __forceinline__ unsigned xb_add(unsigned* p, unsigned v) { return __hip_atomic_fetch_add(p, v, __ATOMIC_RELAXED, __HIP_MEMORY_SCOPE_AGENT); }
__device__ __forceinline__ unsigned xb_xcc_id() { return (unsigned)__builtin_amdgcn_s_getreg((3 << 11) | 20) & 0xFu; }
#define XB_SPIN(cond, bar) do { unsigned _sp = 0; while (cond) { __builtin_amdgcn_s_sleep(1); \
    if ((++_sp & 255u) == 0u) { if (xb_ld(&(bar)[XB_TMO])) break; if (_sp > XB_SPIN_CAP) { atomicAdd(&(bar)[XB_TMO], 1u); break; } } } } while (0)

struct XcdBarrier {
    unsigned* bar; unsigned x;
    volatile LAS unsigned* st;
};

__device__ __forceinline__ XcdBarrier xcd_barrier_post(unsigned* bar, volatile LAS unsigned* st) {
    XcdBarrier b; b.bar = bar; b.x = xb_xcc_id(); b.st = st;
    if (threadIdx.x == 0) (void)xb_add(&bar[XB_XCNT(b.x)], 1u);
    return b;
}
__device__ __forceinline__ void xcd_barrier_complete(unsigned* bar, unsigned x, unsigned& nloc, unsigned& nx) {
    const unsigned G = gridDim.x * gridDim.y * gridDim.z;
    unsigned sum, cnt, mine, sp = 0u;
    for (;;) {
        sum = 0u; cnt = 0u; mine = 0u;
#pragma unroll
        for (unsigned j = 0; j < 16; ++j) { const unsigned c = xb_ld(&bar[XB_XCNT(j)]); sum += c; cnt += (c > 0u) ? 1u : 0u; mine = (j == x) ? c : mine; }
        if (sum == G) break;
        __builtin_amdgcn_s_sleep(1);
        if ((++sp & 255u) == 0u) { if (xb_ld(&bar[XB_TMO])) break; if (sp > XB_SPIN_CAP) { atomicAdd(&bar[XB_TMO], 1u); break; } }
    }
    nloc = mine > 0u ? mine : 1u; nx = cnt > 0u ? cnt : 1u;
}

__device__ __forceinline__ void xcd_barrier(const XcdBarrier& b) {
    asm volatile("s_waitcnt vmcnt(0)" ::: "memory");
    __syncthreads();
    if (threadIdx.x == 0) {
        unsigned* bar = b.bar;
        __builtin_amdgcn_s_waitcnt(0);
        unsigned nloc = b.st[0], nx = b.st[1];
        if (nloc == 0u) { xcd_barrier_complete(bar, b.x, nloc, nx); b.st[0] = nloc; b.st[1] = nx; }
        const unsigned old = xb_add(&bar[XB_XSUB(b.x)], 1u);
        const unsigned gen = old / nloc;
        if (old + 1u == (gen + 1u) * nloc) {
            __builtin_amdgcn_fence(__ATOMIC_RELEASE, "agent");
            asm volatile("s_waitcnt vmcnt(0)" ::: "memory");
            const unsigned og = xb_add(&bar[XB_TOP], 1u);
            const unsigned tg = og / nx;
            if (og + 1u == (tg + 1u) * nx) xb_add(&bar[XB_TOPGEN], 1u);
            else XB_SPIN(xb_ld(&bar[XB_TOPGEN]) == tg, bar);
            __builtin_amdgcn_fence(__ATOMIC_ACQUIRE, "agent");
            xb_add(&bar[XB_XGEN(b.x)], 1u);
            asm volatile("s_waitcnt vmcnt(0)" ::: "memory");
        } else {
            XB_SPIN(xb_ld(&bar[XB_XGEN(b.x)]) == gen, bar);
            __builtin_amdgcn_fence(__ATOMIC_ACQUIRE, "agent");
            asm volatile("s_waitcnt vmcnt(0)" ::: "memory");
        }
    }
    __syncthreads();
}

__global__ void __launch_bounds__(NTHREADS, 2) fwd_megakernel(Args a) {
    extern __shared__ __attribute__((aligned(16))) unsigned char lds[];
    cg::grid_group grid = cg::this_grid();
    const int ph_hi = a.ph_hi < 22 ? a.ph_hi : 22;
    if (threadIdx.x < 64) ((LAS unsigned*)(lds + LDS_MISC))[threadIdx.x] = 0u;
    __syncthreads();
    { typedef const __attribute__((address_space(4))) Args* ArgsP0; ArgsP0 ap0 = (ArgsP0)__builtin_amdgcn_kernarg_segment_ptr();
      (void)xcd_barrier_post((unsigned*)(ap0->ws + WS_BAR), (volatile LAS unsigned*)(lds + LDS_MISC)); }
#pragma nounroll
    for (int p = a.ph_lo; p < ph_hi; ++p) {
        typedef const __attribute__((address_space(4))) Args* ArgsP;
        ArgsP ap = (ArgsP)__builtin_amdgcn_kernarg_segment_ptr(); asm volatile("" : "+s"(ap));
        int pp = p; asm volatile("" : "+s"(pp));
        int G0_ = gridDim.x, bx0_ = blockIdx.x; asm volatile("" : "+s"(G0_), "+s"(bx0_));
        const int G_ = G0_, bx = bx0_;
        const int vcu = (G_ % 8 == 0) ? (bx % 8) * (G_ / 8) + bx / 8 : bx;
#define TIDS() int tid_ = threadIdx.x; asm volatile("" : "+v"(tid_)); const int lane = tid_ & 63, wave = __builtin_amdgcn_readfirstlane(tid_ >> 6); \
        const int gw = vcu * 8 + wave, ngw = G_ * 8, gt = gw * 64 + lane, ngt = ngw * 64; (void)gt; (void)ngt; (void)gw; (void)ngw
        unsigned char* ws = ap->ws;
        PG8_LAS unsigned char* lds3 = (PG8_LAS unsigned char*)lds;
        const int q_ = pp - 1, jj = q_ / 10, r = q_ - jj * 10;
        const int rr_ = pp == 0 ? 10 : (pp == 21 ? 11 : r);
        bf16_t* XB = (bf16_t*)ap->out;
        switch (rr_) {
        case 11: { TIDS(); final_norm((const float*)(ws + WS_XF), ap->out, (const float*)ap->in[21], gw, ngw, lane); } break;
        case 10: { TIDS();
            prep_weights(ap, lds, wave, lane, gw, ngw);
            conv_rows_bf16((const float*)ap->in[0], XB, (float*)(ws + WS_SSX), gw, ngw, lane);
        } break;
        case 0: {
            int K_ = 1024; asm volatile("" : "+s"(K_)); pg8::Gemm g{XB, (const bf16_t*)(ws + WS_W + (size_t)jj * SZ_MLA), T, 2304, K_}; pg8::StaticOrder S; S.init(T, 2304, G_, bx);
            pg8::EpiMlaIn E{ws, (const int*)ap->in[1]};
            pg8::gemm_phase<pg8::EpiMlaIn, pg8::StaticOrder, true, true>(lds3, g, S, E);
        } break;
        case 1: {
            { int K_ = 768; asm volatile("" : "+s"(K_)); pg8::Gemm g{(const bf16_t*)(ws + WS_QLAT), (const bf16_t*)(ws + WS_W + (size_t)jj * SZ_MLA + SZ_MWIN), T, 1536, K_}; pg8::StaticOrder S; S.init(T, 1536, G_, bx);
              pg8::EpiUq E{ws, (const int*)ap->in[1]};
              pg8::gemm_phase<pg8::EpiUq, pg8::StaticOrder, true, true>(lds3, g, S, E); }
            { int K_ = 256; asm volatile("" : "+s"(K_)); pg8::Gemm g{(const bf16_t*)(ws + WS_KVLAT), (const bf16_t*)(ws + WS_W + (size_t)jj * SZ_MLA + SZ_MWIN + SZ_MWUQ), T, 2048, K_}; pg8::StaticOrder S; S.init(T, 2048, G_, bx);
              pg8::EpiUkv E{ws};
              pg8::gemm_phase<pg8::EpiUkv, pg8::StaticOrder, true, true>(lds3, g, S, E); }
        } break;
        case 2: { att::attn_phase(ws, (char*)lds, vcu, G_); } break;
        case 3: case 9: {
            const size_t woff = r == 3 ? WS_W + (size_t)jj * SZ_MLA + SZ_MWIN + SZ_MWUQ + SZ_MWUKV : WS_W + 2 * SZ_MLA + (size_t)jj * SZ_RWKV + SZ_RWIN + SZ_RWL;
            int K_ = 1024; asm volatile("" : "+s"(K_)); pg8::Gemm g{(const bf16_t*)(ws + WS_BUFA), (const bf16_t*)(ws + woff), T, 1024, K_}; pg8::StaticOrder S; S.init(T, 1024, G_, bx);
            pg8::EpiResid E{XB, (float*)(ws + WS_SSX), pp == 20 ? (float*)(ws + WS_XF) : (float*)nullptr};
            pg8::gemm_phase<pg8::EpiResid, pg8::StaticOrder, true, true>(lds3, g, S, E);
        } break;
        case 4: {
            int K_ = 1024; asm volatile("" : "+s"(K_)); pg8::Gemm g{XB, (const bf16_t*)(ws + WS_W + 2 * SZ_MLA + (size_t)jj * SZ_RWKV), T, 4352, K_}; pg8::StaticOrder S; S.init(T, 4352, G_, bx);
            pg8::EpiRwkvIn E{ws};
            pg8::gemm_phase<pg8::EpiRwkvIn, pg8::StaticOrder, true, true>(lds3, g, S, E);
        } break;
        case 5: { TIDS(); lora_in_phase((const float*)(ws + WS_LARAW), (const float*)ap->in[10] + jj * 4224, (bf16_t*)(ws + WS_LA), gt, ngt); } break;
        case 6: {
            int K_ = 128; asm volatile("" : "+s"(K_)); pg8::Gemm g{(const bf16_t*)(ws + WS_LA), (const bf16_t*)(ws + WS_W + 2 * SZ_MLA + (size_t)jj * SZ_RWKV + SZ_RWIN), T, 2048, K_}; pg8::StaticOrder S; S.init(T, 2048, G_, bx);
            pg8::EpiLora E{ws, (const float*)ap->in[11] + jj * 1024, (const float*)ap->in[13] + jj * 1024};
            pg8::gemm_phase<pg8::EpiLora, pg8::StaticOrder, true, true>(lds3, g, S, E);
        } break;
        case 7: {
            for (int item = vcu; item < 256; item += G_)
                scan::scan_item(item, ws, (const float*)ap->in[10] + jj * 4224, (const float*)ap->in[15] + jj * 1024, (const float*)ap->in[16] + jj * 1024, (const float*)ap->in[17] + jj * 1024, (char*)lds);
        } break;
        default: { TIDS();
            post_phase(ws, (const float*)ap->in[10] + jj * 4224, (const float*)ap->in[18] + jj * 1024, (const float*)ap->in[19] + jj * 1024, gt, ngt);
        } break;
        }
        if (p + 1 < ph_hi) {
            if (p == a.ph_lo) grid.sync();
            else { XcdBarrier xb; xb.bar = (unsigned*)(ws + WS_BAR); xb.x = xb_xcc_id(); xb.st = (volatile LAS unsigned*)(lds + LDS_MISC); xcd_barrier(xb); }
        }
    }
}

extern "C" void kernel_launch(void* const* d_in, const int* in_sizes, int n_in, void* d_out, int out_size, void* d_ws, size_t ws_size, hipStream_t stream) {
    static int grid = 0;
    if (grid == 0) {
        if (n_in != 22 || in_sizes[0] != T * DM || out_size != T * DM || ws_size < WS_END) {
            fprintf(stderr, "kernel_launch: unexpected shapes (n_in %d, in0 %d, out %d, ws %zu, need %zu); nothing launched\n", n_in, n_in > 0 ? in_sizes[0] : -1, out_size, ws_size, (size_t)WS_END);
            grid = -1; return; }
        int dev = 0, cus = 0, per_cu = 0;
        (void)hipGetDevice(&dev);
        (void)hipDeviceGetAttribute(&cus, hipDeviceAttributeMultiprocessorCount, dev);
        if (hipFuncSetAttribute((const void*)fwd_megakernel, hipFuncAttributeMaxDynamicSharedMemorySize, LDS_BYTES) != hipSuccess) fprintf(stderr, "kernel_launch: hipFuncSetAttribute failed\n");
        if (hipOccupancyMaxActiveBlocksPerMultiprocessor(&per_cu, (const void*)fwd_megakernel, NTHREADS, LDS_BYTES) != hipSuccess || per_cu < 1) { fprintf(stderr, "kernel_launch: occupancy query gave %d\n", per_cu); per_cu = 1; }
        (void)hipGetLastError();
        if (cus <= 0) cus = 256;
        grid = cus * per_cu;
        fprintf(stderr, "kernel_launch: grid %d (cus %d x %d)\n", grid, cus, per_cu);
    }
    if (grid < 0) return;
    if (hipMemsetAsync((char*)d_ws + WS_BAR, 0, BAR_BYTES, stream) != hipSuccess) { fprintf(stderr, "kernel_launch: memset failed\n"); return; }
    Args a{};
    for (int i = 0; i < 22; ++i) a.in[i] = d_in[i];
    a.out = (float*)d_out; a.ws = (unsigned char*)d_ws;
#if defined(MK_MULTI)
    for (int p = 0; p < 22; ++p) { a.ph_lo = p; a.ph_hi = p + 1; hipLaunchKernelGGL(fwd_megakernel, dim3(grid), dim3(NTHREADS), LDS_BYTES, stream, a); }
#else
    a.ph_lo = 0; a.ph_hi = 1000;
    void* args[] = {&a};
    hipError_t e = hipLaunchCooperativeKernel((const void*)fwd_megakernel, dim3(grid), dim3(NTHREADS), args, LDS_BYTES, stream);
    if (e != hipSuccess) fprintf(stderr, "kernel_launch: cooperative launch failed: %s (grid %d)\n", hipGetErrorString(e), grid);
#endif
}
```

```cpp
#include <hip/hip_runtime.h>
#include <hip/hip_cooperative_groups.h>
#include <cstdio>
#include <cstdint>
#include <cmath>
namespace cg = cooperative_groups;
namespace pg8 {
#define PG8_LAS __attribute__((address_space(3)))
typedef unsigned short bf16_t;
typedef short bf16x8 __attribute__((ext_vector_type(8)));
typedef float f32x4 __attribute__((ext_vector_type(4)));
typedef unsigned u32x4 __attribute__((ext_vector_type(4)));
constexpr int BM = 256, BK = 64, HALF = 128, HTB = HALF * BK * 2  , STAGE_BYTES = 8 * HTB, NXCD = 8, WGM = 8;

__host__ __device__ __forceinline__ int lds_byte(int r, int c) { const int st = (r >> 4) * 2 + (c >> 5), rr = r & 15, cc = c & 31, ob = rr * 64 + cc * 2; return st * 1024 + (ob ^ (((ob >> 9) & 1) << 5)); }
__host__ __device__ __forceinline__ void stage_rc(int b, int& R, int& C) { const int st = b / 1024, sb = b % 1024, swz = sb ^ (((sb >> 9) & 1) << 5); R = (st >> 1) * 16 + swz / 64; C = (st & 1) * 32 + (swz % 64) / 2; }
__host__ __device__ __forceinline__ int perm32(int rho) { const int n = rho >> 4, i = rho & 15; return 8 * (i >> 2) + 4 * n + (i & 3); }

struct Unit { int pm, pn; };
struct Gemm { const bf16_t* A; const bf16_t* Bt; int M, N, K; };

struct StaticOrder {
    int nM, nN, nwg, G, c;
    __host__ __device__ void init(int M, int N, int G_, int c_) { nM = M / BM; nN = N / BM; nwg = nM * nN; G = G_; c = c_; }
    __host__ __device__ bool next(int i, Unit& u) const {
        const long L = (long)i * G + c; if (L >= nwg) return false;
        int wgid = (int)L; { const int q = nwg / NXCD, r = nwg % NXCD, xcd = wgid % NXCD, off = wgid / NXCD; wgid = (xcd < r ? xcd * (q + 1) : r * (q + 1) + (xcd - r) * q) + off; }
        const int nig = WGM * nN, gid = wgid / nig, fm = gid * WGM, gsz = (nM - fm) < WGM ? (nM - fm) : WGM;
        u.pm = fm + ((wgid % nig) % gsz); u.pn = (wgid % nig) / gsz; return true;
    }
    __device__ __forceinline__ void a_ready(const Unit&) const {}
    __device__ __forceinline__ void done(const Unit&) const {}
};

__device__ __forceinline__ unsigned cvt_pk_bf16(float lo, float hi) { unsigned r; asm volatile("v_cvt_pk_bf16_f32 %0, %1, %2" : "=v"(r) : "v"(lo), "v"(hi)); return r; }
typedef float f32x2 __attribute__((ext_vector_type(2)));
template <class Epi, class Sched, bool ALIGN_EPI = false, bool SP2 = false>
__device__ __forceinline__ void gemm_phase(PG8_LAS unsigned char* lds, const Gemm g, const Sched& S, const Epi& E) {
    int tid_ = threadIdx.x; asm volatile("" : "+v"(tid_));
    const int tid = tid_, wid = __builtin_amdgcn_readfirstlane(tid >> 6), lane = tid & 63, wr = wid >> 2, wc = wid & 3, fr = lane & 15, fq = lane >> 4;
    const int K = g.K, nt = K / BK;
    unsigned voffA[2], voffB[2];
#pragma unroll
    for (int i = 0; i < 2; ++i) { int R, C; stage_rc(tid * 16 + i * 8192, R, C); const int Rb = Epi::PERM ? ((R & ~31) + perm32(R & 31)) : R;
        voffA[i] = (unsigned)(R * K + C) * 2u; voffB[i] = (unsigned)(Rb * K + C) * 2u; }
    const size_t kstep = (size_t)(BK * 2);
    const size_t hstep = (size_t)HALF * K * 2;
    const size_t tstep = 2 * hstep;
    const unsigned ldsw = (unsigned)wid * 1024u;
    const int aoff = lds_byte(wr * 64 + fr, fq * 8), boff = lds_byte(wc * 32 + fr, fq * 8);
#define PG8_SA(b, h) (((b) * 2 + (h)) * HTB)
#define PG8_SB(b, h) ((4 + (b) * 2 + (h)) * HTB)
#define PG8_STAGE(bufoff, gbase, voff) do { _Pragma("unroll") for (int _i = 0; _i < 2; ++_i) \
        __builtin_amdgcn_global_load_lds((const unsigned*)((const char*)(gbase) + (voff)[_i]), (PG8_LAS unsigned*)(lds + (bufoff) + ldsw + _i * 8192), 16, 0, 0); } while (0)
#define PG8_LDA(dst, b, h) do { _Pragma("unroll") for (int m = 0; m < 4; ++m) _Pragma("unroll") for (int k = 0; k < 2; ++k) dst[m][k] = *(const PG8_LAS bf16x8*)(lds + PG8_SA(b, h) + aoff + m * 2048 + k * 1024); } while (0)
#define PG8_LDB(dst, b, h) do { _Pragma("unroll") for (int n = 0; n < 2; ++n) _Pragma("unroll") for (int k = 0; k < 2; ++k) dst[n][k] = *(const PG8_LAS bf16x8*)(lds + PG8_SB(b, h) + boff + n * 2048 + k * 1024); } while (0)
#define PG8_MMA(ai, bj, At, Bt) do { __builtin_amdgcn_s_setprio(1); _Pragma("unroll") for (int m = 0; m < 4; ++m) _Pragma("unroll") for (int n = 0; n < 2; ++n) _Pragma("unroll") for (int k = 0; k < 2; ++k) \
        acc[ai][bj][m][n] = __builtin_amdgcn_mfma_f32_16x16x32_bf16(Bt[n][k], At[m][k], acc[ai][bj][m][n], 0, 0, 0); __builtin_amdgcn_s_setprio(0); } while (0)
#define PG8_WAIT_V(n) asm volatile("s_waitcnt vmcnt(" #n ")" ::: "memory")
#define PG8_WAIT_L(n) asm volatile("s_waitcnt lgkmcnt(" #n ")" ::: "memory")
#define PG8_BAR __builtin_amdgcn_s_barrier()
#define PG8_SCHED __builtin_amdgcn_sched_barrier(0)
    Unit cur, nxt; int ui = 0;
    if (!S.next(0, cur)) return;
    f32x4 acc[2][2][4][2];
#pragma unroll
    for (int a = 0; a < 2; ++a)
#pragma unroll
        for (int b = 0; b < 2; ++b)
#pragma unroll
            for (int m = 0; m < 4; ++m)
#pragma unroll
                for (int n = 0; n < 2; ++n) acc[a][b][m][n] = (f32x4){0.f, 0.f, 0.f, 0.f};
    bf16x8 At[4][2], B0[2][2], B1[2][2];
    const char* cA = (const char*)g.A + (size_t)cur.pm * tstep; const char* cB = (const char*)g.Bt + (size_t)cur.pn * tstep;
    S.a_ready(cur);
    if constexpr (SP2) {
        PG8_STAGE(PG8_SB(0, 0), cB, voffB); PG8_STAGE(PG8_SB(0, 1), cB + hstep, voffB); PG8_STAGE(PG8_SA(0, 0), cA, voffA); PG8_STAGE(PG8_SA(0, 1), cA + hstep, voffA);
        if (wr == 1) PG8_BAR;
        PG8_WAIT_V(2); PG8_BAR;
        PG8_STAGE(PG8_SB(1, 0), cB + kstep, voffB); PG8_STAGE(PG8_SA(1, 0), cA + kstep, voffA); PG8_STAGE(PG8_SB(1, 1), cB + hstep + kstep, voffB);
        PG8_WAIT_V(6); PG8_BAR;
    } else {
        PG8_STAGE(PG8_SB(0, 0), cB, voffB); PG8_STAGE(PG8_SA(0, 0), cA, voffA); PG8_STAGE(PG8_SB(0, 1), cB + hstep, voffB); PG8_STAGE(PG8_SA(0, 1), cA + hstep, voffA);
        if (wr == 1) PG8_BAR;
        PG8_WAIT_V(4); PG8_BAR;
        PG8_STAGE(PG8_SB(1, 0), cB + kstep, voffB); PG8_STAGE(PG8_SA(1, 0), cA + kstep, voffA); PG8_STAGE(PG8_SB(1, 1), cB + hstep + kstep, voffB);
        PG8_WAIT_V(6); PG8_BAR;
    }
    for (;;) {
        const bool has_next = S.next(ui + 1, nxt);
        const char* nA = has_next ? (const char*)g.A + (size_t)nxt.pm * tstep : cA; const char* nB = has_next ? (const char*)g.Bt + (size_t)nxt.pn * tstep : cB;
        for (int t = 0; t < nt; t += 2) {
            const bool last = (t == nt - 2);
            const char* a1 = cA + (size_t)(t + 1) * kstep;
            const char* a2 = last ? nA : cA + (size_t)(t + 2) * kstep; const char* b2 = last ? nB : cB + (size_t)(t + 2) * kstep;
            const char* a3 = a2 + kstep; const char* b3 = b2 + kstep;
            if (last && has_next) S.a_ready(nxt);
            if constexpr (SP2) {
            PG8_LDB(B0, 0, 0); PG8_LDB(B1, 0, 1); PG8_SCHED; PG8_LDA(At, 0, 0); PG8_STAGE(PG8_SA(1, 1), a1 + hstep, voffA);
            PG8_WAIT_V(8); PG8_WAIT_L(0); PG8_BAR; PG8_MMA(0, 0, At, B0); PG8_MMA(0, 1, At, B1); PG8_BAR; PG8_SCHED;
            PG8_LDA(At, 0, 1); PG8_STAGE(PG8_SB(0, 0), b2, voffB); PG8_STAGE(PG8_SB(0, 1), b2 + hstep, voffB); PG8_STAGE(PG8_SA(0, 0), a2, voffA);
            PG8_WAIT_V(8); PG8_WAIT_L(0); PG8_BAR; PG8_MMA(1, 0, At, B0); PG8_MMA(1, 1, At, B1); PG8_BAR; PG8_SCHED;
            PG8_LDB(B0, 1, 0); PG8_LDB(B1, 1, 1); PG8_SCHED; PG8_LDA(At, 1, 0); PG8_STAGE(PG8_SA(0, 1), a2 + hstep, voffA);
            PG8_WAIT_V(8); PG8_WAIT_L(0); PG8_BAR; PG8_MMA(0, 0, At, B0); PG8_MMA(0, 1, At, B1); PG8_BAR; PG8_SCHED;
            PG8_LDA(At, 1, 1); PG8_STAGE(PG8_SB(1, 0), b3, voffB); PG8_STAGE(PG8_SB(1, 1), b3 + hstep, voffB); PG8_STAGE(PG8_SA(1, 0), a3, voffA);
            PG8_WAIT_V(8); PG8_WAIT_L(0); PG8_BAR; PG8_MMA(1, 0, At, B0); PG8_MMA(1, 1, At, B1); PG8_BAR; PG8_SCHED;
            } else {
            PG8_LDB(B0, 0, 0); PG8_SCHED; PG8_LDA(At, 0, 0); PG8_STAGE(PG8_SA(1, 1), a1 + hstep, voffA);
            PG8_WAIT_L(8); PG8_BAR; PG8_WAIT_L(0); PG8_MMA(0, 0, At, B0); PG8_BAR; PG8_SCHED;
            PG8_LDB(B1, 0, 1); PG8_STAGE(PG8_SB(0, 0), b2, voffB);
            PG8_BAR; PG8_WAIT_L(0); PG8_MMA(0, 1, At, B1); PG8_BAR;
            PG8_LDA(At, 0, 1); PG8_STAGE(PG8_SA(0, 0), a2, voffA);
            PG8_BAR; PG8_WAIT_L(0); PG8_MMA(1, 0, At, B0); PG8_BAR; PG8_SCHED;
            PG8_STAGE(PG8_SB(0, 1), b2 + hstep, voffB);
            PG8_WAIT_V(6); PG8_BAR; PG8_MMA(1, 1, At, B1); PG8_BAR;
            PG8_LDB(B0, 1, 0); PG8_SCHED; PG8_LDA(At, 1, 0); PG8_STAGE(PG8_SA(0, 1), a2 + hstep, voffA);
            PG8_WAIT_L(8); PG8_BAR; PG8_WAIT_L(0); PG8_MMA(0, 0, At, B0); PG8_BAR; PG8_SCHED;
            PG8_LDB(B1, 1, 1); PG8_STAGE(PG8_SB(1, 0), b3, voffB);
            PG8_BAR; PG8_WAIT_L(0); PG8_MMA(0, 1, At, B1); PG8_BAR;
            PG8_LDA(At, 1, 1); PG8_STAGE(PG8_SA(1, 0), a3, voffA);
            PG8_BAR; PG8_WAIT_L(0); PG8_MMA(1, 0, At, B0); PG8_BAR; PG8_SCHED;
            PG8_STAGE(PG8_SB(1, 1), b3 + hstep, voffB);
            PG8_WAIT_V(6); PG8_BAR; PG8_MMA(1, 1, At, B1); PG8_BAR;
            }
        }
        if constexpr (ALIGN_EPI) { if (wr == 0) PG8_BAR; }
        if constexpr (!Epi::AFTER_DRAIN) { E(acc, cur, wr, wc, fr, fq); S.done(cur); }
        if (!has_next) break;
#pragma unroll
        for (int a = 0; a < 2; ++a)
#pragma unroll
            for (int b = 0; b < 2; ++b)
#pragma unroll
                for (int m = 0; m < 4; ++m)
#pragma unroll
                    for (int n = 0; n < 2; ++n) acc[a][b][m][n] = (f32x4){0.f, 0.f, 0.f, 0.f};
        cur = nxt; cA = nA; cB = nB; ++ui;
        if constexpr (ALIGN_EPI) { if (wr == 1) PG8_BAR; }
    }
    PG8_WAIT_V(0);
    if constexpr (!ALIGN_EPI) { if (wr == 0) PG8_BAR; }
    PG8_BAR;
    if constexpr (Epi::AFTER_DRAIN) { E.fused(acc, cur, wr, wc, fr, fq, lds, wid, lane); S.done(cur); }
#undef PG8_SA
#undef PG8_SB
#undef PG8_STAGE
#undef PG8_LDA
#undef PG8_LDB
#undef PG8_MMA
#undef PG8_WAIT_V
#undef PG8_WAIT_L
#undef PG8_BAR
#undef PG8_SCHED
}
}

typedef pg8::bf16_t bf16_t;
typedef pg8::f32x4 f32x4;
typedef pg8::u32x4 u32x4;
typedef float f32x2 __attribute__((ext_vector_type(2)));
typedef float f32x16 __attribute__((ext_vector_type(16)));
typedef short bf16x8 __attribute__((ext_vector_type(8)));
typedef short s16x4 __attribute__((ext_vector_type(4)));
typedef _Float16 h16x2 __attribute__((ext_vector_type(2)));

constexpr int BATCH = 8, SEQ = 8192, DM = 1024, T = BATCH * SEQ;
constexpr float NORM_EPS = 1e-6f, GN_EPS = 64e-5f;
constexpr size_t MiB = 1u << 20;
constexpr size_t WS_SSQ = 44 * MiB;
constexpr size_t WS_W = 2 * MiB;
constexpr size_t SZ_MWIN = 2304u * 1024 * 2, SZ_MWUQ = 1536u * 768 * 2, SZ_MWUKV = 2048u * 256 * 2, SZ_WOUT = 1024u * 1024 * 2;
constexpr size_t SZ_MLA = SZ_MWIN + SZ_MWUQ + SZ_MWUKV + SZ_WOUT;
constexpr size_t SZ_RWIN = 4352u * 1024 * 2, SZ_RWL = 2048u * 128 * 2;
constexpr size_t SZ_RWKV = SZ_RWIN + SZ_RWL + SZ_WOUT;
static_assert(WS_W + 2 * SZ_MLA + 2 * SZ_RWKV <= 48 * MiB, "weights");
constexpr size_t WS_BUFA = 48 * MiB;
constexpr size_t WS_L = 176 * MiB;
constexpr size_t WS_QLAT = WS_L, WS_KVLAT = WS_L + 96 * MiB, WS_KROPE = WS_L + 128 * MiB, WS_GATE = WS_L + 136 * MiB, WS_Q = WS_L + 264 * MiB,
                 WS_KN = WS_L + 456 * MiB, WS_V = WS_L + 584 * MiB;
constexpr size_t WS_PR = WS_L, WS_LARAW = WS_L + 512 * MiB, WS_LA = WS_L + 544 * MiB, WS_E = WS_L + 560 * MiB, WS_A = WS_L + 688 * MiB;
constexpr size_t WS_SSX = WS_L + 816 * MiB;
constexpr size_t WS_END = WS_SSX + 4 * MiB;
constexpr size_t WS_XF = WS_PR;

constexpr int LDS_BYTES = 131072 + 1024;
constexpr int LDS_MISC = 131072;
constexpr size_t WS_BAR = 0, BAR_BYTES = 16384;
constexpr int NTHREADS = 512;

__device__ const float ROPE_INVF[32] = {
    1.000000000e+00f, 7.498942018e-01f, 5.623413324e-01f, 4.216965139e-01f, 3.162277639e-01f, 2.371373922e-01f, 1.778279394e-01f, 1.333521456e-01f,
    1.000000015e-01f, 7.498941571e-02f, 5.623412877e-02f, 4.216964915e-02f, 3.162277862e-02f, 2.371373586e-02f, 1.778279431e-02f, 1.333521493e-02f,
    9.999999776e-03f, 7.498942316e-03f, 5.623413250e-03f, 4.216964822e-03f, 3.162277862e-03f, 2.371373819e-03f, 1.778279431e-03f, 1.333521446e-03f,
    1.000000047e-03f, 7.498941850e-04f, 5.623413017e-04f, 4.216965463e-04f, 3.162277862e-04f, 2.371373848e-04f, 1.778279402e-04f, 1.333521504e-04f};

__device__ __forceinline__ unsigned cvtpk(float lo, float hi) { return pg8::cvt_pk_bf16(lo, hi); }
__device__ __forceinline__ u32x4 pack8bf(f32x4 a, f32x4 b) { u32x4 w; w.x = cvtpk(a[0], a[1]); w.y = cvtpk(a[2], a[3]); w.z = cvtpk(b[0], b[1]); w.w = cvtpk(b[2], b[3]); return w; }
__device__ __forceinline__ unsigned pkh(float lo, float hi) { h16x2 v = {(_Float16)lo, (_Float16)hi}; return __builtin_bit_cast(unsigned, v); }
__device__ __forceinline__ u32x4 pack8h(f32x4 a, f32x4 b) { u32x4 w; w.x = pkh(a[0], a[1]); w.y = pkh(a[2], a[3]); w.z = pkh(b[0], b[1]); w.w = pkh(b[2], b[3]); return w; }
__device__ __forceinline__ float bf_lo(unsigned w) { return __uint_as_float(w << 16); }
__device__ __forceinline__ float bf_hi(unsigned w) { return __uint_as_float(w & 0xffff0000u); }
__device__ __forceinline__ void unpack8bf(u32x4 w, float* f) { f[0] = bf_lo(w.x); f[1] = bf_hi(w.x); f[2] = bf_lo(w.y); f[3] = bf_hi(w.y); f[4] = bf_lo(w.z); f[5] = bf_hi(w.z); f[6] = bf_lo(w.w); f[7] = bf_hi(w.w); }
__device__ __forceinline__ float h_lo(unsigned w) { return (float)__builtin_bit_cast(_Float16, (unsigned short)(w & 0xffffu)); }
__device__ __forceinline__ float h_hi(unsigned w) { return (float)__builtin_bit_cast(_Float16, (unsigned short)(w >> 16)); }
__device__ __forceinline__ void unpack8h(u32x4 w, float* f) { f[0] = h_lo(w.x); f[1] = h_hi(w.x); f[2] = h_lo(w.y); f[3] = h_hi(w.y); f[4] = h_lo(w.z); f[5] = h_hi(w.z); f[6] = h_lo(w.w); f[7] = h_hi(w.w); }
__device__ __forceinline__ float sigmoidf_(float z) { return __builtin_amdgcn_rcpf(1.f + __expf(-z)); }
__device__ __forceinline__ float siluf_(float z) { return z * sigmoidf_(z); }
__device__ __forceinline__ float wave_sum(float v) {
#pragma unroll
    for (int o = 1; o < 64; o <<= 1) v += __shfl_xor(v, o);
    return v;
}
__device__ __forceinline__ void rope_sc(int pos, int i, float& s, float& c) {
    const float ang = (float)pos * ROPE_INVF[i];
    double rev = (double)ang * 0.15915494309189535;
    rev -= __builtin_floor(rev);
    const float fr = (float)rev;
    s = __builtin_amdgcn_sinf(fr); c = __builtin_amdgcn_cosf(fr);
}
__device__ __forceinline__ void rope8(f32x4& v0, f32x4& v1, int pos, int i0) {
    float s, c, a, b;
    rope_sc(pos, i0, s, c);     a = v0[0]; b = v0[1]; v0[0] = a * c - b * s; v0[1] = b * c + a * s;
    rope_sc(pos, i0 + 1, s, c); a = v0[2]; b = v0[3]; v0[2] = a * c - b * s; v0[3] = b * c + a * s;
    rope_sc(pos, i0 + 2, s, c); a = v1[0]; b = v1[1]; v1[0] = a * c - b * s; v1[1] = b * c + a * s;
    rope_sc(pos, i0 + 3, s, c); a = v1[2]; b = v1[3]; v1[2] = a * c - b * s; v1[3] = b * c + a * s;
}

namespace pg8 {
__device__ __forceinline__ float row_rstd(const float* ssx, int row) {
    const f32x4 s0 = *(const f32x4*)(ssx + (size_t)row * 16), s1 = *(const f32x4*)(ssx + (size_t)row * 16 + 4), s2 = *(const f32x4*)(ssx + (size_t)row * 16 + 8), s3 = *(const f32x4*)(ssx + (size_t)row * 16 + 12);
    const float t = (((s0[0] + s0[1]) + (s0[2] + s0[3])) + ((s1[0] + s1[1]) + (s1[2] + s1[3]))) + (((s2[0] + s2[1]) + (s2[2] + s2[3])) + ((s3[0] + s3[1]) + (s3[2] + s3[3])));
    return __builtin_amdgcn_rsqf(t * (1.0f / 1024.0f) + NORM_EPS);
}
struct EpiMlaIn {
    static constexpr bool PERM = true, AFTER_DRAIN = false;
    unsigned char* ws; const int* pos;
    __device__ __forceinline__ void operator()(const f32x4 (&acc)[2][2][4][2], const Unit& u, int wr, int wc, int fr, int fq) const {
        const int ct = u.pn; const int row0 = u.pm * BM + wr * 64 + fr;
        bf16_t* qlat = (bf16_t*)(ws + WS_QLAT); bf16_t* kvlat = (bf16_t*)(ws + WS_KVLAT); bf16_t* krope = (bf16_t*)(ws + WS_KROPE); bf16_t* gate = (bf16_t*)(ws + WS_GATE); float* ssq = (float*)(ws + WS_SSQ);
#pragma unroll
        for (int ai = 0; ai < 2; ++ai)
#pragma unroll
            for (int m = 0; m < 4; ++m) {
                const int row = row0 + ai * HALF + m * 16;
                const float rs = row_rstd((const float*)(ws + WS_SSX), row);
                if (ct <= 3) {
                    float s = 0.f;
#pragma unroll
                    for (int bj = 0; bj < 2; ++bj) { const f32x4 v0 = acc[ai][bj][m][0] * rs, v1 = acc[ai][bj][m][1] * rs; const int cc = bj * HALF + wc * 32 + 8 * fq;
                        s += (v0[0] * v0[0] + v0[1] * v0[1]) + (v0[2] * v0[2] + v0[3] * v0[3]) + (v1[0] * v1[0] + v1[1] * v1[1]) + (v1[2] * v1[2] + v1[3] * v1[3]);
                        if (ct < 3) __builtin_nontemporal_store(pack8bf(v0, v1), (u32x4*)(qlat + (size_t)row * 768 + ct * 256 + cc));
                        else __builtin_nontemporal_store(pack8bf(v0, v1), (u32x4*)(kvlat + (size_t)row * 256 + cc)); }
                    s += __shfl_xor(s, 16); s += __shfl_xor(s, 32);
                    if (fq == 0) ssq[(size_t)row * 16 + ct * 4 + wc] = s;
                } else if (ct == 4) {
                    if (wc < 2) { f32x4 v0 = acc[ai][0][m][0] * rs, v1 = acc[ai][0][m][1] * rs; const int cc = wc * 32 + 8 * fq;
                        rope8(v0, v1, pos[row], cc >> 1);
                        __builtin_nontemporal_store(pack8bf(v0, v1), (u32x4*)(krope + (size_t)row * 64 + cc)); }
                } else {
#pragma unroll
                    for (int bj = 0; bj < 2; ++bj) { f32x4 v0 = acc[ai][bj][m][0] * rs, v1 = acc[ai][bj][m][1] * rs; const int cc = bj * HALF + wc * 32 + 8 * fq;
#pragma unroll
                        for (int e = 0; e < 4; ++e) { v0[e] = siluf_(v0[e]); v1[e] = siluf_(v1[e]); }
                        __builtin_nontemporal_store(pack8bf(v0, v1), (u32x4*)(gate + (size_t)row * 1024 + (ct - 5) * 256 + cc)); }
                }
            }
    }
};
struct EpiUq {
    static constexpr bool PERM = true, AFTER_DRAIN = false;
    unsigned char* ws; const int* pos;
    __device__ __forceinline__ void operator()(const f32x4 (&acc)[2][2][4][2], const Unit& u, int wr, int wc, int fr, int fq) const {
        const int ct = u.pn; const int row0 = u.pm * BM + wr * 64 + fr; bf16_t* q = (bf16_t*)(ws + WS_Q); const float* ssq = (const float*)(ws + WS_SSQ);
#pragma unroll
        for (int ai = 0; ai < 2; ++ai)
#pragma unroll
            for (int m = 0; m < 4; ++m) {
                const int row = row0 + ai * HALF + m * 16;
                float ssum;
                { const f32x4 s0 = *(const f32x4*)(ssq + (size_t)row * 16), s1 = *(const f32x4*)(ssq + (size_t)row * 16 + 4), s2 = *(const f32x4*)(ssq + (size_t)row * 16 + 8);
                  ssum = (((s0[0] + s0[1]) + (s0[2] + s0[3])) + ((s1[0] + s1[1]) + (s1[2] + s1[3]))) + ((s2[0] + s2[1]) + (s2[2] + s2[3])); }
                const float rs = __builtin_amdgcn_rsqf(ssum * (1.0f / 768.0f) + NORM_EPS);
                int ps = 0; if (ct >= 4) ps = pos[row];
#pragma unroll
                for (int bj = 0; bj < 2; ++bj) { f32x4 v0 = acc[ai][bj][m][0] * rs, v1 = acc[ai][bj][m][1] * rs; const int cc = bj * HALF + wc * 32 + 8 * fq;
                    if (ct < 4) { const int col = ct * 256 + cc, h = col >> 7, d = col & 127;
                        __builtin_nontemporal_store(pack8bf(v0, v1), (u32x4*)(q + (size_t)row * 1536 + h * 192 + d)); }
                    else { const int col = (ct - 4) * 256 + cc, h = col >> 6, p = col & 63;
                        rope8(v0, v1, ps, p >> 1);
                        __builtin_nontemporal_store(pack8bf(v0, v1), (u32x4*)(q + (size_t)row * 1536 + h * 192 + 128 + p)); } }
            }
    }
};
struct EpiUkv {
    static constexpr bool PERM = true, AFTER_DRAIN = false;
    unsigned char* ws;
    __device__ __forceinline__ void operator()(const f32x4 (&acc)[2][2][4][2], const Unit& u, int wr, int wc, int fr, int fq) const {
        const int row0 = u.pm * BM + wr * 64 + fr; bf16_t* kn = (bf16_t*)(ws + WS_KN); bf16_t* v = (bf16_t*)(ws + WS_V); const float* ssq = (const float*)(ws + WS_SSQ);
#pragma unroll
        for (int ai = 0; ai < 2; ++ai)
#pragma unroll
            for (int m = 0; m < 4; ++m) {
                const int row = row0 + ai * HALF + m * 16;
                const f32x4 s3 = *(const f32x4*)(ssq + (size_t)row * 16 + 12);
                const float rs = __builtin_amdgcn_rsqf(((s3[0] + s3[1]) + (s3[2] + s3[3])) * (1.0f / 256.0f) + NORM_EPS);
                const size_t off = (size_t)row * 1024 + u.pn * 128 + wc * 32 + 8 * fq;
                __builtin_nontemporal_store(pack8bf(acc[ai][0][m][0] * rs, acc[ai][0][m][1] * rs), (u32x4*)(kn + off));
                __builtin_nontemporal_store(pack8bf(acc[ai][1][m][0] * rs, acc[ai][1][m][1] * rs), (u32x4*)(v + off));
            }
    }
};
struct EpiResid {
    static constexpr bool PERM = true, AFTER_DRAIN = false;
    bf16_t* xb; float* ssx; float* xf;
    __device__ __forceinline__ void operator()(const f32x4 (&acc)[2][2][4][2], const Unit& u, int wr, int wc, int fr, int fq) const {
        const int row0 = u.pm * BM + wr * 64 + fr;
#pragma unroll
        for (int ai = 0; ai < 2; ++ai)
#pragma unroll
            for (int m = 0; m < 4; ++m) { const int row = row0 + ai * HALF + m * 16; float s = 0.f;
#pragma unroll
                for (int bj = 0; bj < 2; ++bj) { const size_t off = (size_t)row * DM + u.pn * BM + bj * HALF + wc * 32 + 8 * fq;
                    const u32x4 xw = *(const u32x4*)(xb + off);
                    f32x4 v0 = acc[ai][bj][m][0], v1 = acc[ai][bj][m][1];
                    v0[0] += bf_lo(xw.x); v0[1] += bf_hi(xw.x); v0[2] += bf_lo(xw.y); v0[3] += bf_hi(xw.y); v1[0] += bf_lo(xw.z); v1[1] += bf_hi(xw.z); v1[2] += bf_lo(xw.w); v1[3] += bf_hi(xw.w);
                    if (xf) { *(f32x4*)(xf + off) = v0; *(f32x4*)(xf + off + 4) = v1; }
                    else { const u32x4 ow = pack8bf(v0, v1); *(u32x4*)(xb + off) = ow;
                        const float a0 = bf_lo(ow.x), a1 = bf_hi(ow.x), a2 = bf_lo(ow.y), a3 = bf_hi(ow.y), a4 = bf_lo(ow.z), a5 = bf_hi(ow.z), a6 = bf_lo(ow.w), a7 = bf_hi(ow.w);
                        s += ((a0 * a0 + a1 * a1) + (a2 * a2 + a3 * a3)) + ((a4 * a4 + a5 * a5) + (a6 * a6 + a7 * a7)); } }
                if (!xf) { s += __shfl_xor(s, 16); s += __shfl_xor(s, 32); if (fq == 0) ssx[(size_t)row * 16 + u.pn * 4 + wc] = s; } }
    }
};
struct EpiRwkvIn {
    static constexpr bool PERM = true, AFTER_DRAIN = false;
    unsigned char* ws;
    __device__ __forceinline__ void operator()(const f32x4 (&acc)[2][2][4][2], const Unit& u, int wr, int wc, int fr, int fq) const {
        const int ct = u.pn; const int row0 = u.pm * BM + wr * 64 + fr; bf16_t* pr = (bf16_t*)(ws + WS_PR); float* laraw = (float*)(ws + WS_LARAW);
#pragma unroll
        for (int ai = 0; ai < 2; ++ai)
#pragma unroll
            for (int m = 0; m < 4; ++m) {
                const int row = row0 + ai * HALF + m * 16;
                const float rs = row_rstd((const float*)(ws + WS_SSX), row);
                if (ct < 16) {
#pragma unroll
                    for (int bj = 0; bj < 2; ++bj) { const int cc = bj * HALF + wc * 32 + 8 * fq; __builtin_nontemporal_store(pack8bf(acc[ai][bj][m][0] * rs, acc[ai][bj][m][1] * rs), (u32x4*)(pr + (size_t)row * 4096 + ct * 256 + cc)); }
                } else { const int cc = wc * 32 + 8 * fq; float* d = laraw + (size_t)row * 128 + cc; *(f32x4*)d = acc[ai][0][m][0] * rs; *(f32x4*)(d + 4) = acc[ai][0][m][1] * rs; }
            }
    }
};
struct EpiLora {
    static constexpr bool PERM = true, AFTER_DRAIN = false;
    unsigned char* ws; const float* w0; const float* a0;
    __device__ __forceinline__ void operator()(const f32x4 (&acc)[2][2][4][2], const Unit& u, int wr, int wc, int fr, int fq) const {
        const int ct = u.pn; const int row0 = u.pm * BM + wr * 64 + fr; _Float16* E = (_Float16*)(ws + WS_E); _Float16* A = (_Float16*)(ws + WS_A);
        const bool isw = ct < 4; const float* bias = isw ? w0 : a0; _Float16* dst = isw ? E : A; const float mul = isw ? 0.6065306597126334f : 1.0f;
        const int cb = (isw ? ct : ct - 4) * 256 + wc * 32 + 8 * fq;
#pragma unroll
        for (int bj = 0; bj < 2; ++bj) { const int c = cb + bj * HALF;
            const f32x4 b0 = *(const f32x4*)(bias + c), b1 = *(const f32x4*)(bias + c + 4);
#pragma unroll
            for (int ai = 0; ai < 2; ++ai)
#pragma unroll
                for (int m = 0; m < 4; ++m) { const int row = row0 + ai * HALF + m * 16;
                    f32x4 v0 = acc[ai][bj][m][0] + b0, v1 = acc[ai][bj][m][1] + b1;
#pragma unroll
                    for (int e = 0; e < 4; ++e) { v0[e] = sigmoidf_(v0[e]) * mul; v1[e] = sigmoidf_(v1[e]) * mul; }
                    __builtin_nontemporal_store(pack8h(v0, v1), (u32x4*)(dst + (size_t)row * 1024 + c)); } }
    }
};
}

#define LASF __attribute__((address_space(3)))
__device__ __forceinline__ int il64(int i) { return 2 * (i & 31) + (i >> 5); }
__device__ __forceinline__ int rowmap(int mode, int n) {
    if (mode == 1) return n < 1024 ? n : (n < 1088 ? 1024 + il64(n - 1024) : n + 192);
    if (mode == 2) { const int h = n / 192, w = n - h * 192; return w < 128 ? h * 128 + w : 1024 + h * 64 + il64(w - 128); }
    if (mode == 3) return n + 1024;
    return n;
}
__device__ __forceinline__ void transpose_item(const float* W, int N, bf16_t* WT, int ldk, float* scr, int item, int lane, const float* kscale, float gscale, int mode) {
    const int nblk = N / 32, kb = item / nblk, nb = item - kb * nblk, k0 = 64 * kb, n0 = 32 * nb;
#pragma unroll 8
    for (int i = 0; i < 32; ++i) { const int kk = 2 * i + (lane >> 5); const float sc = kscale ? kscale[k0 + kk] * gscale : gscale;
        scr[kk * 33 + (lane & 31)] = W[(size_t)(k0 + kk) * N + n0 + (lane & 31)] * sc; }
    asm volatile("s_waitcnt lgkmcnt(0)" ::: "memory");
    const int c = lane & 7;
#pragma unroll
    for (int j = 0; j < 4; ++j) { const int n = (lane >> 3) + 8 * j; const float* s = scr + (8 * c) * 33 + n;
        u32x4 o; o.x = cvtpk(s[0 * 33], s[1 * 33]); o.y = cvtpk(s[2 * 33], s[3 * 33]); o.z = cvtpk(s[4 * 33], s[5 * 33]); o.w = cvtpk(s[6 * 33], s[7 * 33]);
        *(u32x4*)(WT + (size_t)rowmap(mode, n0 + n) * ldk + k0 + 8 * c) = o; }
    asm volatile("s_waitcnt lgkmcnt(0)" ::: "memory");
}
struct Args { const void* in[22]; float* out; unsigned char* ws; int ph_lo, ph_hi; };

template <class AP> __device__ __forceinline__ void prep_weights(AP ap, unsigned char* lds, int wave, int lane, int gw, int ngw) {
    float* scr = (float*)(lds + wave * 16384);
    constexpr int PER = 5088;
    const float QSCALE = 0.07216878364870322f * 1.4426950408889634f;
#pragma nounroll
    for (int it = gw; it < 2 * PER; it += ngw) {
        const int j = it / PER; int r = it - j * PER;
        unsigned char* mb = ap->ws + WS_W + (size_t)j * SZ_MLA; unsigned char* rb = ap->ws + WS_W + 2 * SZ_MLA + (size_t)j * SZ_RWKV;
        const float* W; int N; bf16_t* WT; int ldk; const float* ks = nullptr; float gs = 1.f; int mode = 0;
        if (r < 1056) { W = (const float*)ap->in[3] + (size_t)j * 1024 * 2112; N = 2112; WT = (bf16_t*)mb; ldk = 1024; ks = (const float*)ap->in[2] + (2 * j) * 1024; mode = 1; }
        else if ((r -= 1056) < 576) { W = (const float*)ap->in[5] + (size_t)j * 768 * 1536; N = 1536; WT = (bf16_t*)(mb + SZ_MWIN); ldk = 768; ks = (const float*)ap->in[4] + j * 768; gs = QSCALE; mode = 2; }
        else if ((r -= 576) < 256) { W = (const float*)ap->in[7] + (size_t)j * 256 * 2048; N = 2048; WT = (bf16_t*)(mb + SZ_MWIN + SZ_MWUQ); ldk = 256; ks = (const float*)ap->in[6] + j * 256; }
        else if ((r -= 256) < 512) { W = (const float*)ap->in[8] + (size_t)j * 1024 * 1024; N = 1024; WT = (bf16_t*)(mb + SZ_MWIN + SZ_MWUQ + SZ_MWUKV); ldk = 1024; }
        else if ((r -= 512) < 2112) { W = (const float*)ap->in[9] + (size_t)j * 1024 * 4224; N = 4224; WT = (bf16_t*)rb; ldk = 1024; ks = (const float*)ap->in[2] + (2 * j + 1) * 1024; }
        else if ((r -= 2112) < 32) { W = (const float*)ap->in[12] + (size_t)j * 64 * 1024; N = 1024; WT = (bf16_t*)(rb + SZ_RWIN); ldk = 128; }
        else if ((r -= 32) < 32) { W = (const float*)ap->in[14] + (size_t)j * 64 * 1024; N = 1024; WT = (bf16_t*)(rb + SZ_RWIN) + 64; ldk = 128; mode = 3; }
        else { r -= 32; W = (const float*)ap->in[20] + (size_t)j * 1024 * 1024; N = 1024; WT = (bf16_t*)(rb + SZ_RWIN + SZ_RWL); ldk = 1024; }
        transpose_item(W, N, WT, ldk, scr, r, lane, ks, gs, mode);
    }
    const int gt = gw * 64 + lane, ngt = ngw * 64;
    constexpr int Z0 = 24576, Z1 = 16384, Z2 = 16384, ZT = Z0 + Z1 + Z2;
    unsigned zz = 0u; asm volatile("" : "+v"(zz)); const u32x4 z = {zz, zz, zz, zz};
    for (int it = gt; it < 2 * ZT; it += ngt) {
        const int j = it / ZT; int r = it - j * ZT;
        unsigned char* mb = ap->ws + WS_W + (size_t)j * SZ_MLA; unsigned char* rb = ap->ws + WS_W + 2 * SZ_MLA + (size_t)j * SZ_RWKV;
        if (r < Z0) *(u32x4*)(mb + (size_t)1088 * 2048 + (size_t)r * 16) = z;
        else if ((r -= Z0) < Z1) *(u32x4*)(rb + (size_t)4224 * 2048 + (size_t)r * 16) = z;
        else { r -= Z1; const int row = r >> 3, u = r & 7; *(u32x4*)(rb + SZ_RWIN + (size_t)row * 256 + (row < 1024 ? 128 : 0) + u * 16) = z; }
    }
}

__device__ __forceinline__ void conv_rows_bf16(const float* X, bf16_t* XB, float* ssx, int gw, int ngw, int lane) {
    f32x4 cur[4], nxt[4];
    if (gw < T) {
#pragma unroll
        for (int j = 0; j < 4; ++j) cur[j] = ((const f32x4*)(X + (size_t)gw * DM) + lane)[64 * j]; }
    for (int m = gw; m < T; m += ngw) {
        const int mn = m + ngw < T ? m + ngw : m;
#pragma unroll
        for (int j = 0; j < 4; ++j) nxt[j] = ((const f32x4*)(X + (size_t)mn * DM) + lane)[64 * j];
        unsigned long long* o8 = (unsigned long long*)(XB + (size_t)m * DM) + lane; float s = 0.f;
#pragma unroll
        for (int j = 0; j < 4; ++j) { const f32x4 v = cur[j]; const unsigned w0 = cvtpk(v[0], v[1]), w1 = cvtpk(v[2], v[3]);
            const float a0 = bf_lo(w0), a1 = bf_hi(w0), a2 = bf_lo(w1), a3 = bf_hi(w1); s += (a0 * a0 + a1 * a1) + (a2 * a2 + a3 * a3);
            o8[64 * j] = (unsigned long long)w0 | ((unsigned long long)w1 << 32); }
        s = wave_sum(s);
        if (lane < 16) ssx[(size_t)m * 16 + lane] = lane == 0 ? s : 0.f;
#pragma unroll
        for (int j = 0; j < 4; ++j) cur[j] = nxt[j];
    }
}
__device__ __forceinline__ void final_norm(const float* X, float* out, const float* g, int gw, int ngw, int lane) {
    f32x4 gv[4], cur[4], nxt[4];
#pragma unroll
    for (int j = 0; j < 4; ++j) gv[j] = ((const f32x4*)g)[lane + 64 * j];
    if (gw < T) {
#pragma unroll
        for (int j = 0; j < 4; ++j) cur[j] = ((const f32x4*)(X + (size_t)gw * DM) + lane)[64 * j]; }
    for (int m = gw; m < T; m += ngw) {
        const int mn = m + ngw < T ? m + ngw : m;
#pragma unroll
        for (int j = 0; j < 4; ++j) nxt[j] = ((const f32x4*)(X + (size_t)mn * DM) + lane)[64 * j];
        f32x4* orow = (f32x4*)(out + (size_t)m * DM) + lane; float s = 0.f;
#pragma unroll
        for (int j = 0; j < 4; ++j) s += (cur[j][0] * cur[j][0] + cur[j][1] * cur[j][1]) + (cur[j][2] * cur[j][2] + cur[j][3] * cur[j][3]);
        const float rstd = 1.0f / sqrtf(wave_sum(s) * (1.f / DM) + NORM_EPS);
#pragma unroll
        for (int j = 0; j < 4; ++j) orow[64 * j] = cur[j] * rstd * gv[j];
#pragma unroll
        for (int j = 0; j < 4; ++j) cur[j] = nxt[j];
    }
}

namespace att {
constexpr int KP = 400, KBUF = 64 * KP, VBUF = 16384;
constexpr int OFF_K = 0, OFF_V = 2 * KBUF, OFF_WS = OFF_V + 2 * VBUF, ATT_LDS = OFF_WS + 8 * 64 * 4;
static_assert(ATT_LDS <= 131072, "attention LDS");
constexpr float THR2 = 11.0f;
#define SBAR() __builtin_amdgcn_sched_barrier(0)
__device__ __forceinline__ int v_st(int k, int c) { const int kk = (k & ~0xC) | ((k & 4) << 1) | ((k & 8) >> 1); return ((kk >> 3) * 4 + (c >> 5)) * 512 + ((kk & 7) * 32 + (c & 31)) * 2; }
__device__ __forceinline__ int v_rd_base(int lane) { return ((lane & 3) << 3) | (((lane >> 2) & 3) << 6) | (((lane >> 4) & 1) << 5) | (((lane >> 5) & 1) << 8); }
constexpr int v_rd_off(int d0, int ks, int half) { return d0 * 512 + ks * 4096 + half * 2048; }
__device__ __forceinline__ int crow(int r, int hi) { return (r & 3) + 8 * (r >> 2) + 4 * hi; }

__device__ __forceinline__ void mask_tile(f32x16& p0, f32x16& p1, int dq) {
    const float NEG = -__builtin_inff();
#pragma unroll
    for (int r = 0; r < 16; ++r) {
        const int c = (r & 3) + 8 * (r >> 2);
        if (dq - c < 0) p0[r] = NEG;
        if (dq - c - 32 < 0) p1[r] = NEG;
    }
}
__device__ __forceinline__ void softmax_tile(f32x16& p0, f32x16& p1, float& m_reg, float& l_reg, float& alpha, bf16x8& pa0, bf16x8& pa1, bf16x8& pa2, bf16x8& pa3) {
    float pmax = p0[0];
#pragma unroll
    for (int r = 1; r < 16; ++r) pmax = fmaxf(pmax, p0[r]);
#pragma unroll
    for (int r = 0; r < 16; ++r) pmax = fmaxf(pmax, p1[r]);
    { auto rr = __builtin_amdgcn_permlane32_swap(__float_as_uint(pmax), __float_as_uint(pmax), false, false);
      pmax = fmaxf(__uint_as_float(rr[0]), __uint_as_float(rr[1])); }
    float mn;
    if (__builtin_expect(__all((pmax - m_reg) <= THR2), 1)) { mn = m_reg; alpha = 1.f; }
    else { mn = fmaxf(m_reg, pmax); alpha = __builtin_amdgcn_exp2f(m_reg - mn); m_reg = mn; }
#pragma unroll
    for (int r = 0; r < 16; ++r) p0[r] = __builtin_amdgcn_exp2f(p0[r] - mn);
#pragma unroll
    for (int r = 0; r < 16; ++r) p1[r] = __builtin_amdgcn_exp2f(p1[r] - mn);
    f32x2 ps2 = {0.f, 0.f};
#pragma unroll
    for (int r = 0; r < 16; r += 2) { ps2 += (f32x2){p0[r], p0[r + 1]}; ps2 += (f32x2){p1[r], p1[r + 1]}; }
    float ps = ps2[0] + ps2[1];
    { auto rr = __builtin_amdgcn_permlane32_swap(__float_as_uint(ps), __float_as_uint(ps), false, false);
      ps = __uint_as_float(rr[0]) + __uint_as_float(rr[1]); }
    l_reg = l_reg * alpha + ps;
#define PK4(P, B_, OUT) do { unsigned a0 = cvtpk(P[B_+0], P[B_+1]), a1 = cvtpk(P[B_+2], P[B_+3]);                          \
        unsigned b0 = cvtpk(P[B_+4], P[B_+5]), b1 = cvtpk(P[B_+6], P[B_+7]);                                             \
        auto r0 = __builtin_amdgcn_permlane32_swap(a0, b0, false, false); auto r1 = __builtin_amdgcn_permlane32_swap(a1, b1, false, false); \
        u32x4 w = {r0[0], r1[0], r0[1], r1[1]}; OUT = *reinterpret_cast<bf16x8*>(&w); } while (0)
    PK4(p0, 0, pa0); PK4(p0, 8, pa1); PK4(p1, 0, pa2); PK4(p1, 8, pa3);
#undef PK4
}
template <int KB>
__device__ __forceinline__ void qkt(f32x16& p0, f32x16& p1, const char* K_lds, int r32, int hi, const bf16x8* qr) {
    p0 = f32x16{}; p1 = f32x16{};
    const int kaddr = (int)(uintptr_t)K_lds + r32 * KP + hi * 16;
    bf16x8 f0, f1, f2, f3;
#define KRD(dst, i) asm volatile("ds_read_b128 %0, %1 offset:%2" : "=v"(dst) : "v"(kaddr), "i"(KB * KBUF + ((i) >> 1) * 32 + ((i) & 1) * 32 * KP) : "memory")
#define KMM(f, i, W) do { asm volatile("s_waitcnt lgkmcnt(%1)" : "+v"(f) : "n"(W) : "memory"); \
        if ((i) & 1) p1 = __builtin_amdgcn_mfma_f32_32x32x16_bf16(f, qr[(i) >> 1], p1, 0, 0, 0); else p0 = __builtin_amdgcn_mfma_f32_32x32x16_bf16(f, qr[(i) >> 1], p0, 0, 0, 0); \
        if ((i) + 4 < 24) KRD(f, (i) + 4); } while (0)
    KRD(f0, 0); KRD(f1, 1); KRD(f2, 2); KRD(f3, 3);
    KMM(f0, 0, 3); KMM(f1, 1, 3); KMM(f2, 2, 3); KMM(f3, 3, 3); KMM(f0, 4, 3); KMM(f1, 5, 3); KMM(f2, 6, 3); KMM(f3, 7, 3);
    KMM(f0, 8, 3); KMM(f1, 9, 3); KMM(f2, 10, 3); KMM(f3, 11, 3); KMM(f0, 12, 3); KMM(f1, 13, 3); KMM(f2, 14, 3); KMM(f3, 15, 3);
    KMM(f0, 16, 3); KMM(f1, 17, 3); KMM(f2, 18, 3); KMM(f3, 19, 3); KMM(f0, 20, 3); KMM(f1, 21, 2); KMM(f2, 22, 1); KMM(f3, 23, 0);
#undef KMM
#undef KRD
}
template <int VB>
__device__ __forceinline__ void pv_tile(f32x16* o, int vb0, bf16x8 pa0, bf16x8 pa1, bf16x8 pa2, bf16x8 pa3) {
#define TRRD(dst, off) asm volatile("ds_read_b64_tr_b16 %0, %1 offset:%2" : "=v"(dst) : "v"(vb0), "i"(off) : "memory")
#define PV_RD(S, d0) do { constexpr int b_ = VB * VBUF + v_rd_off(d0, 0, 0); \
        TRRD(S##l0, b_); TRRD(S##h0, b_ + 2048); TRRD(S##l1, b_ + 4096); TRRD(S##h1, b_ + 6144); TRRD(S##l2, b_ + 8192); TRRD(S##h2, b_ + 10240); TRRD(S##l3, b_ + 12288); TRRD(S##h3, b_ + 14336); } while (0)
#define PV_MM(S, d0, W) do { asm volatile("s_waitcnt lgkmcnt(%8)" : "+v"(S##l0), "+v"(S##h0), "+v"(S##l1), "+v"(S##h1), "+v"(S##l2), "+v"(S##h2), "+v"(S##l3), "+v"(S##h3) : "n"(W) : "memory"); \
        o[d0] = __builtin_amdgcn_mfma_f32_32x32x16_bf16(pa0, (bf16x8){S##l0[0], S##l0[1], S##l0[2], S##l0[3], S##h0[0], S##h0[1], S##h0[2], S##h0[3]}, o[d0], 0, 0, 0);   \
        o[d0] = __builtin_amdgcn_mfma_f32_32x32x16_bf16(pa1, (bf16x8){S##l1[0], S##l1[1], S##l1[2], S##l1[3], S##h1[0], S##h1[1], S##h1[2], S##h1[3]}, o[d0], 0, 0, 0);   \
        o[d0] = __builtin_amdgcn_mfma_f32_32x32x16_bf16(pa2, (bf16x8){S##l2[0], S##l2[1], S##l2[2], S##l2[3], S##h2[0], S##h2[1], S##h2[2], S##h2[3]}, o[d0], 0, 0, 0);   \
        o[d0] = __builtin_amdgcn_mfma_f32_32x32x16_bf16(pa3, (bf16x8){S##l3[0], S##l3[1], S##l3[2], S##l3[3], S##h3[0], S##h3[1], S##h3[2], S##h3[3]}, o[d0], 0, 0, 0); } while (0)
    s16x4 Al0, Al1, Al2, Al3, Ah0, Ah1, Ah2, Ah3, Bl0, Bl1, Bl2, Bl3, Bh0, Bh1, Bh2, Bh3;
    PV_RD(A, 0); PV_RD(B, 1);
    PV_MM(A, 0, 8); PV_RD(A, 2);
    PV_MM(B, 1, 8); PV_RD(B, 3);
    PV_MM(A, 2, 8);
    PV_MM(B, 3, 0);
#undef PV_MM
#undef PV_RD
#undef TRRD
}
__device__ __forceinline__ void attn_unit(int b, int h, int qb, const bf16_t* Q, const bf16_t* KN, const bf16_t* KR, const bf16_t* V, const bf16_t* G, bf16_t* O, char* lds) {
    int tid_ = threadIdx.x; asm volatile("" : "+v"(tid_));
    const int tid = tid_, wid = __builtin_amdgcn_readfirstlane(tid >> 6), lane = tid & 63, r32 = lane & 31, hi = lane >> 5;
    const size_t rowbase = (size_t)b * SEQ; const int q0 = qb * 256;
    char* V_lds = lds + OFF_V; char* K_lds = lds + OFF_K;
    float* wsf = (float*)(lds + OFF_WS) + wid * 64; float* li_l = wsf; float* al_l = wsf + 32;
    const int NT = (q0 + 256) / 64;
    const int qlo = q0 + wid * 32, qm = qlo + r32 - 4 * hi;
    const int sr = tid >> 4, sc = (tid & 15) * 8, vst0 = v_st(sr, sc), vst1 = v_st(32 + sr, sc), kws = sr * KP + sc * 2;
    const int rr = tid >> 3, rc = (tid & 7) * 8, krs = rr * KP + 256 + rc * 2;
    const int vb0 = (int)(uintptr_t)V_lds + v_rd_base(lane);
    const bf16_t* Kh = KN + rowbase * 1024 + h * 128 + sc; const bf16_t* Vh = V + rowbase * 1024 + h * 128 + sc; const bf16_t* Rh = KR + rowbase * 64 + rc;
    bf16x8 qr[12];
    { const bf16_t* qp = Q + (rowbase + qlo + r32) * 1536 + h * 192 + hi * 8;
#pragma unroll
      for (int d0 = 0; d0 < 12; ++d0) qr[d0] = *reinterpret_cast<const bf16x8*>(qp + d0 * 16); }
    bf16x8 sk0, sk1, skr, sv0, sv1;
#define LOADG(t) do { const size_t k0_ = (size_t)(t) * 64; sk0 = *(const bf16x8*)(Kh + (k0_ + sr) * 1024); sk1 = *(const bf16x8*)(Kh + (k0_ + 32 + sr) * 1024); \
        skr = *(const bf16x8*)(Rh + (k0_ + rr) * 64); sv0 = *(const bf16x8*)(Vh + (k0_ + sr) * 1024); sv1 = *(const bf16x8*)(Vh + (k0_ + 32 + sr) * 1024); } while (0)
#define WRITEL(bf) do { *(bf16x8*)(K_lds + (bf) * KBUF + kws) = sk0; *(bf16x8*)(K_lds + (bf) * KBUF + kws + 32 * KP) = sk1; *(bf16x8*)(K_lds + (bf) * KBUF + krs) = skr; \
        *(bf16x8*)(V_lds + (bf) * VBUF + vst0) = sv0; *(bf16x8*)(V_lds + (bf) * VBUF + vst1) = sv1; } while (0)
    float m_reg = -1e30f, l_reg = 0.f; f32x16 o[4] = {};
    f32x16 p0, p1; bf16x8 pa0, pa1, pa2, pa3; float alpha;
    LOADG(0); WRITEL(0); LOADG(1); __syncthreads();
#define STEP(BUF, t) do { \
        if ((t) + 1 < NT) WRITEL((BUF) ^ 1); \
        if ((t) + 2 < NT) LOADG((t) + 2); \
        if ((t) * 64 <= qlo + 31) {     \
        SBAR(); __builtin_amdgcn_s_setprio(1); qkt<BUF>(p0, p1, K_lds, r32, hi, qr); __builtin_amdgcn_s_setprio(0); \
        { const int kb_ = (t) * 64; if (kb_ + 63 > qlo) mask_tile(p0, p1, qm - kb_); } \
        softmax_tile(p0, p1, m_reg, l_reg, alpha, pa0, pa1, pa2, pa3); \
        if (__any(alpha < 1.f)) { if (hi == 0) al_l[r32] = alpha; asm volatile("s_waitcnt lgkmcnt(0)" ::: "memory"); \
            _Pragma("unroll") for (int d_ = 0; d_ < 4; ++d_) _Pragma("unroll") for (int r = 0; r < 16; ++r) o[d_][r] *= al_l[crow(r, hi)]; } \
        SBAR(); __builtin_amdgcn_s_setprio(1); pv_tile<BUF>(o, vb0, pa0, pa1, pa2, pa3); __builtin_amdgcn_s_setprio(0); } \
        __syncthreads(); } while (0)
    for (int t = 0; t < NT; t += 2) { STEP(0, t); STEP(1, t + 1); }
#undef STEP
#undef LOADG
#undef WRITEL
    if (hi == 0) li_l[r32] = l_reg; asm volatile("s_waitcnt lgkmcnt(0)" ::: "memory");
    const size_t obase = (rowbase + qlo) * 1024 + h * 128 + r32;
#pragma unroll
    for (int r = 0; r < 16; ++r) { const int orow = crow(r, hi); const float rli = __builtin_amdgcn_rcpf(li_l[orow]);
#pragma unroll
        for (int d0 = 0; d0 < 4; ++d0) { const size_t off = obase + (size_t)orow * 1024 + d0 * 32;
            const float gv = __uint_as_float(((unsigned)G[off]) << 16);
            const float v = o[d0][r] * rli * gv; const float vn = __shfl_xor(v, 1);
            if ((r32 & 1) == 0) *(unsigned*)(O + off) = cvtpk(v, vn); } }
    __syncthreads();
}
__device__ __forceinline__ void attn_phase(unsigned char* ws, char* lds, int vcu, int G_) {
    const bf16_t* Q = (const bf16_t*)(ws + WS_Q); const bf16_t* KN = (const bf16_t*)(ws + WS_KN); const bf16_t* KR = (const bf16_t*)(ws + WS_KROPE); const bf16_t* V = (const bf16_t*)(ws + WS_V); const bf16_t* G = (const bf16_t*)(ws + WS_GATE); bf16_t* O = (bf16_t*)(ws + WS_BUFA);
    for (int L = vcu; L < 1024; L += G_) { const int bh = L >> 4, x = L & 15;
        attn_unit(bh >> 3, bh & 7, 31 - x, Q, KN, KR, V, G, O, lds);
        attn_unit(bh >> 3, bh & 7, x, Q, KN, KR, V, G, O, lds); }
}
#undef SBAR
}

__device__ __forceinline__ float tanhf_(float x) { return 1.f - 2.f * __builtin_amdgcn_rcpf(__expf(2.f * x) + 1.f); }
__device__ __forceinline__ void lora_in_phase(const float* laraw, const float* mu  , bf16_t* la, int gt, int ngt) {
    for (int idx = gt; idx < T * 16; idx += ngt) {
        const int t = idx >> 4, g = idx & 15, c0 = g * 8; const int s = t & (SEQ - 1);
        const float* p = laraw + (size_t)t * 128 + c0;
        f32x4 r0 = *(const f32x4*)p, r1 = *(const f32x4*)(p + 4), q0 = {0.f, 0.f, 0.f, 0.f}, q1 = q0;
        if (s > 0) { q0 = *(const f32x4*)(p - 128); q1 = *(const f32x4*)(p - 124); }
        const f32x4 m0 = *(const f32x4*)(mu + 4096 + c0), m1 = *(const f32x4*)(mu + 4096 + c0 + 4);
        f32x4 v0 = r0 + m0 * (q0 - r0), v1 = r1 + m1 * (q1 - r1);
        if (g < 8) {
#pragma unroll
            for (int e = 0; e < 4; ++e) { v0[e] = tanhf_(v0[e]); v1[e] = tanhf_(v1[e]); } }
        *(u32x4*)(la + (size_t)t * 128 + c0) = pack8bf(v0, v1);
    }
}
namespace scan {
constexpr int STEP_F = 356, STEPB = STEP_F * 4, CH = 32, BUFB = CH * STEPB, OFF_Y = 2 * BUFB, YB = CH * 32 * 4, OFF_YD = OFF_Y + 2 * YB  , SCAN_LDS = OFF_YD + 512 * 4;
static_assert(SCAN_LDS <= 131072, "scan LDS");
template <int CTRL> __device__ __forceinline__ float dpp_add(float x) {
    return x + __builtin_bit_cast(float, __builtin_amdgcn_update_dpp(0, __builtin_bit_cast(int, x), CTRL, 0xf, 0xf, true));
}
__device__ __forceinline__ float allred16(float x) { x = dpp_add<0xB1>(x); x = dpp_add<0x4E>(x); x = dpp_add<0x141>(x); x = dpp_add<0x140>(x); return x; }

__device__ __forceinline__ void scan_item(int item, unsigned char* ws, const float* mu, const float* k_k, const float* k_a, const float* r_k, char* lds) {
    const bf16_t* PR = (const bf16_t*)(ws + WS_PR); const _Float16* E = (const _Float16*)(ws + WS_E); const _Float16* A = (const _Float16*)(ws + WS_A); bf16_t* Y = (bf16_t*)(ws + WS_BUFA); float* BON = (float*)(ws + WS_SSQ);
    int tid_ = threadIdx.x; asm volatile("" : "+v"(tid_));
    const int tid = tid_, wid = __builtin_amdgcn_readfirstlane(tid >> 6), lane = tid & 63;
    const int bh = item >> 1, half = item & 1, b = bh >> 4, h = bh & 15;
    const size_t rowbase = (size_t)b * SEQ;
    constexpr int NCH = SEQ / CH;
    typedef unsigned u32x2 __attribute__((ext_vector_type(2)));
    const int ls = tid >> 4, lq = tid & 15, c0 = h * 64 + lq * 4;
    const f32x4 mr = *(const f32x4*)(mu + c0), mk = *(const f32x4*)(mu + 1024 + c0), mv = *(const f32x4*)(mu + 2048 + c0), kkp = *(const f32x4*)(k_k + c0), kap = *(const f32x4*)(k_a + c0), rkp = *(const f32x4*)(r_k + c0);
    const bool myv = (lq >> 3) == half;
    u32x2 g_rt, g_kt, g_vt, g_rp, g_kp, g_vp, g_et, g_at;
#define SC_LOAD(cn) do { const int sg_ = (cn) * CH + ls; const bf16_t* pr_ = PR + (rowbase + sg_) * 4096 + c0; \
        g_rt = *(const u32x2*)pr_; g_kt = *(const u32x2*)(pr_ + 1024); g_vt = *(const u32x2*)(pr_ + 2048); \
        const bf16_t* pp_ = sg_ > 0 ? pr_ - 4096 : pr_; g_rp = *(const u32x2*)pp_; g_kp = *(const u32x2*)(pp_ + 1024); g_vp = *(const u32x2*)(pp_ + 2048); \
        g_et = *(const u32x2*)(E + (rowbase + sg_) * 1024 + c0); g_at = *(const u32x2*)(A + (rowbase + sg_) * 1024 + c0); } while (0)
#define SC_CVT(cn) do { const float pm_ = ((cn) * CH + ls) > 0 ? 1.f : 0.f; \
        f32x4 r_ = {bf_lo(g_rt.x), bf_hi(g_rt.x), bf_lo(g_rt.y), bf_hi(g_rt.y)}, k_ = {bf_lo(g_kt.x), bf_hi(g_kt.x), bf_lo(g_kt.y), bf_hi(g_kt.y)}, v_ = {bf_lo(g_vt.x), bf_hi(g_vt.x), bf_lo(g_vt.y), bf_hi(g_vt.y)}; \
        const f32x4 rq_ = (f32x4){bf_lo(g_rp.x), bf_hi(g_rp.x), bf_lo(g_rp.y), bf_hi(g_rp.y)} * pm_, kq_ = (f32x4){bf_lo(g_kp.x), bf_hi(g_kp.x), bf_lo(g_kp.y), bf_hi(g_kp.y)} * pm_, vq_ = (f32x4){bf_lo(g_vp.x), bf_hi(g_vp.x), bf_lo(g_vp.y), bf_hi(g_vp.y)} * pm_; \
        const f32x4 e_ = {h_lo(g_et.x), h_hi(g_et.x), h_lo(g_et.y), h_hi(g_et.y)}, a_ = {h_lo(g_at.x), h_hi(g_at.x), h_lo(g_at.y), h_hi(g_at.y)}; \
        r_ += mr * (rq_ - r_); k_ += mk * (kq_ - k_); v_ += mv * (vq_ - v_); \
        const f32x4 kkv_ = k_ * kkp; float ss_ = (kkv_[0] * kkv_[0] + kkv_[1] * kkv_[1]) + (kkv_[2] * kkv_[2] + kkv_[3] * kkv_[3]); ss_ = allred16(ss_); \
        const float inv_ = __builtin_amdgcn_rsqf(fmaxf(ss_, 1e-24f)); const f32x4 kk_ = kkv_ * inv_;     \
        float* st_ = (float*)(lds + ((cn) & 1) * BUFB + ls * STEPB) + lq * 4; \
        *(f32x4*)(st_) = -kk_; \
        *(f32x4*)(st_ + 64) = (f32x4){__expf(-e_[0]), __expf(-e_[1]), __expf(-e_[2]), __expf(-e_[3])}; \
        *(f32x4*)(st_ + 128) = kk_ * a_; \
        const f32x4 kf_ = k_ * ((a_ - 1.f) * kap + 1.f); *(f32x4*)(st_ + 192) = kf_; \
        if (half == 0) { const f32x4 bq_ = r_ * kf_ * rkp; float bn_ = allred16((bq_[0] + bq_[1]) + (bq_[2] + bq_[3])); if (lq == 0) BON[(rowbase + (size_t)(cn) * CH + ls) * 16 + h] = bn_; } \
        *(f32x4*)(st_ + 256) = r_; \
        if (myv) *(f32x4*)((float*)(lds + ((cn) & 1) * BUFB + ls * STEPB) + 320 + (lq & 7) * 4) = v_; } while (0)
#define SC_YOUT(cn) do { if (lq < 8) { const f32x4 y_ = *(const f32x4*)((const float*)(lds + OFF_Y + ((cn) & 1) * YB) + ls * 32 + lq * 4); \
        u32x2 o_; o_.x = cvtpk(y_[0], y_[1]); o_.y = cvtpk(y_[2], y_[3]); \
        *(u32x2*)(Y + (rowbase + (size_t)(cn) * CH + ls) * 1024 + h * 64 + half * 32 + lq * 4) = o_; } } while (0)
    const int cgp = lane & 15, row = wid * 4 + (lane >> 4);
    f32x4 S = {0.f, 0.f, 0.f, 0.f};
    SC_LOAD(0); SC_CVT(0);
    __syncthreads();
    for (int c = 0; c < NCH; ++c) {
        if (c > 0) SC_YOUT(c - 1);
        if (c + 1 < NCH) SC_LOAD(c + 1);
        const float* base = (const float*)(lds + (c & 1) * BUFB) + cgp * 4;
        const float* vbp = (const float*)(lds + (c & 1) * BUFB) + 320 + row;
        float* yb = (float*)(lds + OFF_Y + (c & 1) * YB) + row;
        float* ybw = cgp == 0 ? yb : (float*)(lds + OFF_YD) + wid * 64 + lane; const int ybs = cgp == 0 ? 32 : 0;
        f32x4 a4 = *(const f32x4*)(base), w4 = *(const f32x4*)(base + 64), b4 = *(const f32x4*)(base + 128), k4 = *(const f32x4*)(base + 192), r4 = *(const f32x4*)(base + 256);
        float v1 = *vbp; float ypart = 0.f;
#pragma unroll 4
        for (int s = 0; s < CH; ++s) {
            const int sn = s + 1;
            const float* st = base + sn * STEP_F;
            const f32x4 na4 = *(const f32x4*)(st), nw4 = *(const f32x4*)(st + 64), nb4 = *(const f32x4*)(st + 128), nk4 = *(const f32x4*)(st + 192), nr4 = *(const f32x4*)(st + 256);
            const float nv1 = vbp[sn * STEP_F];
            float p = (S[0] * a4[0] + S[1] * a4[1]) + (S[2] * a4[2] + S[3] * a4[3]);
            p = dpp_add<0xB1>(p); ypart = dpp_add<0xB1>(ypart); p = dpp_add<0x4E>(p); ypart = dpp_add<0x4E>(ypart);
            p = dpp_add<0x141>(p); ypart = dpp_add<0x141>(ypart); p = dpp_add<0x140>(p); ypart = dpp_add<0x140>(ypart);
            if (s > 0) ybw[(s - 1) * ybs] = ypart;
            S = S * w4 + (b4 * p + k4 * v1);
            ypart = (S[0] * r4[0] + S[1] * r4[1]) + (S[2] * r4[2] + S[3] * r4[3]);
            a4 = na4; w4 = nw4; b4 = nb4; k4 = nk4; r4 = nr4; v1 = nv1;
        }
        ypart = allred16(ypart);
        ybw[(CH - 1) * ybs] = ypart;
        if (c + 1 < NCH) SC_CVT(c + 1);
        __syncthreads();
    }
    SC_YOUT(NCH - 1);
    __syncthreads();
#undef SC_LOAD
#undef SC_CVT
#undef SC_YOUT
}
}

__device__ __forceinline__ void post_phase(unsigned char* ws, const float* mu, const float* ln_g, const float* ln_b, int gt, int ngt) {
    const bf16_t* PR = (const bf16_t*)(ws + WS_PR); bf16_t* Y = (bf16_t*)(ws + WS_BUFA); const float* BON = (const float*)(ws + WS_SSQ);
    const int g = gt & 127, c0 = g * 8;
    const f32x4 mv0 = *(const f32x4*)(mu + 2048 + c0), mv1 = *(const f32x4*)(mu + 2048 + c0 + 4), mg0 = *(const f32x4*)(mu + 3072 + c0), mg1 = *(const f32x4*)(mu + 3072 + c0 + 4);
    const f32x4 lg0 = *(const f32x4*)(ln_g + c0), lg1 = *(const f32x4*)(ln_g + c0 + 4), lb0 = *(const f32x4*)(ln_b + c0), lb1 = *(const f32x4*)(ln_b + c0 + 4);
    u32x4 n_vt, n_gt, n_vp, n_gp, n_yt; float n_bon;
#define POST_LOAD(ix) do { const int t_ = (ix) >> 7; const bf16_t* pr_ = PR + (size_t)t_ * 4096 + c0; const int pv_ = (t_ & (SEQ - 1)) > 0 ? 4096 : 0; \
        n_vt = *(const u32x4*)(pr_ + 2048); n_gt = *(const u32x4*)(pr_ + 3072); n_vp = *(const u32x4*)(pr_ - pv_ + 2048); n_gp = *(const u32x4*)(pr_ - pv_ + 3072); \
        n_yt = *(const u32x4*)(Y + (size_t)t_ * 1024 + c0); n_bon = BON[(size_t)t_ * 16 + (g >> 3)]; } while (0)
    if (gt < T * 128) POST_LOAD(gt);
    for (int idx = gt; idx < T * 128; idx += ngt) {
        const int t = idx >> 7; const int s = t & (SEQ - 1);
        const u32x4 vt = n_vt, gt_ = n_gt, yt = n_yt; u32x4 vp = n_vp, gp = n_gp; const float bon = n_bon;
        if (s == 0) { vp = (u32x4){0u, 0u, 0u, 0u}; gp = vp; }
        { const int nx = idx + ngt < T * 128 ? idx + ngt : idx; POST_LOAD(nx); }
        float v_[8], g_[8], vq[8], gq[8], y_[8];
        unpack8bf(vt, v_); unpack8bf(gt_, g_); unpack8bf(vp, vq); unpack8bf(gp, gq); unpack8bf(yt, y_);
        float ysum = 0.f;
#pragma unroll
        for (int e = 0; e < 8; ++e) { const float mve = e < 4 ? mv0[e & 3] : mv1[e & 3], mge = e < 4 ? mg0[e & 3] : mg1[e & 3];
            v_[e] += mve * (vq[e] - v_[e]); g_[e] += mge * (gq[e] - g_[e]); ysum += y_[e]; }
        ysum += __shfl_xor(ysum, 1); ysum += __shfl_xor(ysum, 2); ysum += __shfl_xor(ysum, 4);
        const float mean = ysum * (1.f / 64.f); float var = 0.f;
#pragma unroll
        for (int e = 0; e < 8; ++e) { const float d = y_[e] - mean; var += d * d; }
        var += __shfl_xor(var, 1); var += __shfl_xor(var, 2); var += __shfl_xor(var, 4);
        const float rstd = 1.0f / sqrtf(var * (1.f / 64.f) + GN_EPS);
        f32x4 o0, o1;
#pragma unroll
        for (int e = 0; e < 8; ++e) { const float lge = e < 4 ? lg0[e & 3] : lg1[e & 3], lbe = e < 4 ? lb0[e & 3] : lb1[e & 3];
            const float yn = (y_[e] - mean) * rstd * lge + lbe + bon * v_[e];
            const float ov = yn * siluf_(g_[e]);
            if (e < 4) o0[e] = ov; else o1[e - 4] = ov; }
        *(u32x4*)(Y + (size_t)t * 1024 + c0) = pack8bf(o0, o1);
    }
#undef POST_LOAD
}

#define LAS __attribute__((address_space(3)))
#define XB_TMO      128
#define XB_XCNT(j)  (256  + 64 * (j))
#define XB_XSUB(j)  (1280 + 64 * (j))
#define XB_XGEN(j)  (2304 + 64 * (j))
#define XB_TOP      3328
#define XB_TOPGEN   3392
#define XCD_BAR_WORDS 3456
#define XB_SPIN_CAP (1u << 18)

__device__ __forceinline__ unsigned xb_ld(unsigned* p)              { return __hip_atomic_load(p, __ATOMIC_RELAXED, __HIP_MEMORY_SCOPE_AGENT); }
__device__ __forceinline__ unsigned xb_add(unsigned* p, unsigned v) { return __hip_atomic_fetch_add(p, v, __ATOMIC_RELAXED, __HIP_MEMORY_SCOPE_AGENT); }
__device__ __forceinline__ unsigned xb_xcc_id() { return (unsigned)__builtin_amdgcn_s_getreg((3 << 11) | 20) & 0xFu; }
#define XB_SPIN(cond, bar) do { unsigned _sp = 0; while (cond) { __builtin_amdgcn_s_sleep(1); \
    if ((++_sp & 255u) == 0u) { if (xb_ld(&(bar)[XB_TMO])) break; if (_sp > XB_SPIN_CAP) { atomicAdd(&(bar)[XB_TMO], 1u); break; } } } } while (0)

struct XcdBarrier {
    unsigned* bar; unsigned x;
    volatile LAS unsigned* st;
};

__device__ __forceinline__ XcdBarrier xcd_barrier_post(unsigned* bar, volatile LAS unsigned* st) {
    XcdBarrier b; b.bar = bar; b.x = xb_xcc_id(); b.st = st;
    if (threadIdx.x == 0) (void)xb_add(&bar[XB_XCNT(b.x)], 1u);
    return b;
}
__device__ __forceinline__ void xcd_barrier_complete(unsigned* bar, unsigned x, unsigned& nloc, unsigned& nx) {
    const unsigned G = gridDim.x * gridDim.y * gridDim.z;
    unsigned sum, cnt, mine, sp = 0u;
    for (;;) {
        sum = 0u; cnt = 0u; mine = 0u;
#pragma unroll
        for (unsigned j = 0; j < 16; ++j) { const unsigned c = xb_ld(&bar[XB_XCNT(j)]); sum += c; cnt += (c > 0u) ? 1u : 0u; mine = (j == x) ? c : mine; }
        if (sum == G) break;
        __builtin_amdgcn_s_sleep(1);
        if ((++sp & 255u) == 0u) { if (xb_ld(&bar[XB_TMO])) break; if (sp > XB_SPIN_CAP) { atomicAdd(&bar[XB_TMO], 1u); break; } }
    }
    nloc = mine > 0u ? mine : 1u; nx = cnt > 0u ? cnt : 1u;
}

__device__ __forceinline__ void xcd_barrier(const XcdBarrier& b) {
    asm volatile("s_waitcnt vmcnt(0)" ::: "memory");
    __syncthreads();
    if (threadIdx.x == 0) {
        unsigned* bar = b.bar;
        __builtin_amdgcn_s_waitcnt(0);
        unsigned nloc = b.st[0], nx = b.st[1];
        if (nloc == 0u) { xcd_barrier_complete(bar, b.x, nloc, nx); b.st[0] = nloc; b.st[1] = nx; }
        const unsigned old = xb_add(&bar[XB_XSUB(b.x)], 1u);
        const unsigned gen = old / nloc;
        if (old + 1u == (gen + 1u) * nloc) {
            __builtin_amdgcn_fence(__ATOMIC_RELEASE, "agent");
            asm volatile("s_waitcnt vmcnt(0)" ::: "memory");
            const unsigned og = xb_add(&bar[XB_TOP], 1u);
            const unsigned tg = og / nx;
            if (og + 1u == (tg + 1u) * nx) xb_add(&bar[XB_TOPGEN], 1u);
            else XB_SPIN(xb_ld(&bar[XB_TOPGEN]) == tg, bar);
            __builtin_amdgcn_fence(__ATOMIC_ACQUIRE, "agent");
            xb_add(&bar[XB_XGEN(b.x)], 1u);
            asm volatile("s_waitcnt vmcnt(0)" ::: "memory");
        } else {
            XB_SPIN(xb_ld(&bar[XB_XGEN(b.x)]) == gen, bar);
            __builtin_amdgcn_fence(__ATOMIC_ACQUIRE, "agent");
            asm volatile("s_waitcnt vmcnt(0)" ::: "memory");
        }
    }
    __syncthreads();
}

__global__ void __launch_bounds__(NTHREADS, 2) fwd_megakernel(Args a) {
    extern __shared__ __attribute__((aligned(16))) unsigned char lds[];
    cg::grid_group grid = cg::this_grid();
    const int ph_hi = a.ph_hi < 22 ? a.ph_hi : 22;
    if (threadIdx.x < 64) ((LAS unsigned*)(lds + LDS_MISC))[threadIdx.x] = 0u;
    __syncthreads();
    { typedef const __attribute__((address_space(4))) Args* ArgsP0; ArgsP0 ap0 = (ArgsP0)__builtin_amdgcn_kernarg_segment_ptr();
      (void)xcd_barrier_post((unsigned*)(ap0->ws + WS_BAR), (volatile LAS unsigned*)(lds + LDS_MISC)); }
#pragma nounroll
    for (int p = a.ph_lo; p < ph_hi; ++p) {
        typedef const __attribute__((address_space(4))) Args* ArgsP;
        ArgsP ap = (ArgsP)__builtin_amdgcn_kernarg_segment_ptr(); asm volatile("" : "+s"(ap));
        int pp = p; asm volatile("" : "+s"(pp));
        int G0_ = gridDim.x, bx0_ = blockIdx.x; asm volatile("" : "+s"(G0_), "+s"(bx0_));
        const int G_ = G0_, bx = bx0_;
        const int vcu = (G_ % 8 == 0) ? (bx % 8) * (G_ / 8) + bx / 8 : bx;
#define TIDS() int tid_ = threadIdx.x; asm volatile("" : "+v"(tid_)); const int lane = tid_ & 63, wave = __builtin_amdgcn_readfirstlane(tid_ >> 6); \
        const int gw = vcu * 8 + wave, ngw = G_ * 8, gt = gw * 64 + lane, ngt = ngw * 64; (void)gt; (void)ngt; (void)gw; (void)ngw
        unsigned char* ws = ap->ws;
        PG8_LAS unsigned char* lds3 = (PG8_LAS unsigned char*)lds;
        const int q_ = pp - 1, jj = q_ / 10, r = q_ - jj * 10;
        const int rr_ = pp == 0 ? 10 : (pp == 21 ? 11 : r);
        bf16_t* XB = (bf16_t*)ap->out;
        switch (rr_) {
        case 11: { TIDS(); final_norm((const float*)(ws + WS_XF), ap->out, (const float*)ap->in[21], gw, ngw, lane); } break;
        case 10: { TIDS();
            prep_weights(ap, lds, wave, lane, gw, ngw);
            conv_rows_bf16((const float*)ap->in[0], XB, (float*)(ws + WS_SSX), gw, ngw, lane);
        } break;
        case 0: {
            int K_ = 1024; asm volatile("" : "+s"(K_)); pg8::Gemm g{XB, (const bf16_t*)(ws + WS_W + (size_t)jj * SZ_MLA), T, 2304, K_}; pg8::StaticOrder S; S.init(T, 2304, G_, bx);
            pg8::EpiMlaIn E{ws, (const int*)ap->in[1]};
            pg8::gemm_phase<pg8::EpiMlaIn, pg8::StaticOrder, true, true>(lds3, g, S, E);
        } break;
        case 1: {
            { int K_ = 768; asm volatile("" : "+s"(K_)); pg8::Gemm g{(const bf16_t*)(ws + WS_QLAT), (const bf16_t*)(ws + WS_W + (size_t)jj * SZ_MLA + SZ_MWIN), T, 1536, K_}; pg8::StaticOrder S; S.init(T, 1536, G_, bx);
              pg8::EpiUq E{ws, (const int*)ap->in[1]};
              pg8::gemm_phase<pg8::EpiUq, pg8::StaticOrder, true, true>(lds3, g, S, E); }
            { int K_ = 256; asm volatile("" : "+s"(K_)); pg8::Gemm g{(const bf16_t*)(ws + WS_KVLAT), (const bf16_t*)(ws + WS_W + (size_t)jj * SZ_MLA + SZ_MWIN + SZ_MWUQ), T, 2048, K_}; pg8::StaticOrder S; S.init(T, 2048, G_, bx);
              pg8::EpiUkv E{ws};
              pg8::gemm_phase<pg8::EpiUkv, pg8::StaticOrder, true, true>(lds3, g, S, E); }
        } break;
        case 2: { att::attn_phase(ws, (char*)lds, vcu, G_); } break;
        case 3: case 9: {
            const size_t woff = r == 3 ? WS_W + (size_t)jj * SZ_MLA + SZ_MWIN + SZ_MWUQ + SZ_MWUKV : WS_W + 2 * SZ_MLA + (size_t)jj * SZ_RWKV + SZ_RWIN + SZ_RWL;
            int K_ = 1024; asm volatile("" : "+s"(K_)); pg8::Gemm g{(const bf16_t*)(ws + WS_BUFA), (const bf16_t*)(ws + woff), T, 1024, K_}; pg8::StaticOrder S; S.init(T, 1024, G_, bx);
            pg8::EpiResid E{XB, (float*)(ws + WS_SSX), pp == 20 ? (float*)(ws + WS_XF) : (float*)nullptr};
            pg8::gemm_phase<pg8::EpiResid, pg8::StaticOrder, true, true>(lds3, g, S, E);
        } break;
        case 4: {
            int K_ = 1024; asm volatile("" : "+s"(K_)); pg8::Gemm g{XB, (const bf16_t*)(ws + WS_W + 2 * SZ_MLA + (size_t)jj * SZ_RWKV), T, 4352, K_}; pg8::StaticOrder S; S.init(T, 4352, G_, bx);
            pg8::EpiRwkvIn E{ws};
            pg8::gemm_phase<pg8::EpiRwkvIn, pg8::StaticOrder, true, true>(lds3, g, S, E);
        } break;
        case 5: { TIDS(); lora_in_phase((const float*)(ws + WS_LARAW), (const float*)ap->in[10] + jj * 4224, (bf16_t*)(ws + WS_LA), gt, ngt); } break;
        case 6: {
            int K_ = 128; asm volatile("" : "+s"(K_)); pg8::Gemm g{(const bf16_t*)(ws + WS_LA), (const bf16_t*)(ws + WS_W + 2 * SZ_MLA + (size_t)jj * SZ_RWKV + SZ_RWIN), T, 2048, K_}; pg8::StaticOrder S; S.init(T, 2048, G_, bx);
            pg8::EpiLora E{ws, (const float*)ap->in[11] + jj * 1024, (const float*)ap->in[13] + jj * 1024};
            pg8::gemm_phase<pg8::EpiLora, pg8::StaticOrder, true, true>(lds3, g, S, E);
        } break;
        case 7: {
            for (int item = vcu; item < 256; item += G_)
                scan::scan_item(item, ws, (const float*)ap->in[10] + jj * 4224, (const float*)ap->in[15] + jj * 1024, (const float*)ap->in[16] + jj * 1024, (const float*)ap->in[17] + jj * 1024, (char*)lds);
        } break;
        default: { TIDS();
            post_phase(ws, (const float*)ap->in[10] + jj * 4224, (const float*)ap->in[18] + jj * 1024, (const float*)ap->in[19] + jj * 1024, gt, ngt);
        } break;
        }
        if (p + 1 < ph_hi) {
            if (p == a.ph_lo) grid.sync();
            else { XcdBarrier xb; xb.bar = (unsigned*)(ws + WS_BAR); xb.x = xb_xcc_id(); xb.st = (volatile LAS unsigned*)(lds + LDS_MISC); xcd_barrier(xb); }
        }
    }
}

extern "C" void kernel_launch(void* const* d_in, const int* in_sizes, int n_in, void* d_out, int out_size, void* d_ws, size_t ws_size, hipStream_t stream) {
    static int grid = 0;
    if (grid == 0) {
        if (n_in != 22 || in_sizes[0] != T * DM || out_size != T * DM || ws_size < WS_END) {
            fprintf(stderr, "kernel_launch: unexpected shapes (n_in %d, in0 %d, out %d, ws %zu, need %zu); nothing launched\n", n_in, n_in > 0 ? in_sizes[0] : -1, out_size, ws_size, (size_t)WS_END);
            grid = -1; return; }
        int dev = 0, cus = 0, per_cu = 0;
        (void)hipGetDevice(&dev);
        (void)hipDeviceGetAttribute(&cus, hipDeviceAttributeMultiprocessorCount, dev);
        if (hipFuncSetAttribute((const void*)fwd_megakernel, hipFuncAttributeMaxDynamicSharedMemorySize, LDS_BYTES) != hipSuccess) fprintf(stderr, "kernel_launch: hipFuncSetAttribute failed\n");
        if (hipOccupancyMaxActiveBlocksPerMultiprocessor(&per_cu, (const void*)fwd_megakernel, NTHREADS, LDS_BYTES) != hipSuccess || per_cu < 1) { fprintf(stderr, "kernel_launch: occupancy query gave %d\n", per_cu); per_cu = 1; }
        (void)hipGetLastError();
        if (cus <= 0) cus = 256;
        grid = cus * per_cu;
        fprintf(stderr, "kernel_launch: grid %d (cus %d x %d)\n", grid, cus, per_cu);
    }
    if (grid < 0) return;
    if (hipMemsetAsync((char*)d_ws + WS_BAR, 0, BAR_BYTES, stream) != hipSuccess) { fprintf(stderr, "kernel_launch: memset failed\n"); return; }
    Args a{};
    for (int i = 0; i < 22; ++i) a.in[i] = d_in[i];
    a.out = (float*)d_out; a.ws = (unsigned char*)d_ws;
#if defined(MK_MULTI)
    for (int p = 0; p < 22; ++p) { a.ph_lo = p; a.ph_hi = p + 1; hipLaunchKernelGGL(fwd_megakernel, dim3(grid), dim3(NTHREADS), LDS_BYTES, stream, a); }
#else
    a.ph_lo = 0; a.ph_hi = 1000;
    void* args[] = {&a};
    hipError_t e = hipLaunchCooperativeKernel((const void*)fwd_megakernel, dim3(grid), dim3(NTHREADS), args, LDS_BYTES, stream);
    if (e != hipSuccess) fprintf(stderr, "kernel_launch: cooperative launch failed: %s (grid %d)\n", hipGetErrorString(e), grid);
#endif
}
```
